# Optimizing an MI355X kernel written in HIP

```python
import jax
import jax.numpy as jnp
from jax import lax
import numpy as np


D_MODEL = 1024
BATCH = 2
SEQ = 8192
DEPTH = 2

GRID_W = 64
EPS = 1e-6
ROPE_THETA = 10000.0
BLOCK = 128
HEAD_DIM = 64
A_Q_HEADS = 8
A_KV_HEADS = 2
WINDOW = 128
B_Q_HEADS = 8
B_KV_HEADS = 2
AB_IN_WIDTHS = (A_Q_HEADS * HEAD_DIM, A_KV_HEADS * HEAD_DIM, A_KV_HEADS * HEAD_DIM,
                B_Q_HEADS * HEAD_DIM, B_KV_HEADS * HEAD_DIM, B_KV_HEADS * HEAD_DIM)
AB_IN = sum(AB_IN_WIDTHS)
AB_OUT = (A_Q_HEADS + B_Q_HEADS) * HEAD_DIM
C_HEADS = 8
C_DK = 128
C_DV = 128
C_CONV = 5
C_CHUNK = 64
C_QK_W = C_HEADS * C_DK
C_V_W = C_HEADS * C_DV
C_IN_WIDTHS = (C_QK_W, C_QK_W, C_V_W, C_V_W, C_HEADS, C_HEADS, C_HEADS, C_HEADS)
C_IN = sum(C_IN_WIDTHS)
C_CONV_W = 2 * C_QK_W + C_V_W
D_FF = 3584
N_EXPERTS = 8
TOP_K = 2
D_FF_EXPERT = 3584
N_EVEN = (DEPTH + 1) // 2
N_ODD = DEPTH // 2

kernel_name = "hybrid_swa_axial_gdn_moe_encoder"

F32 = jnp.float32


def split_cols(t, widths):
    out, start = [], 0
    for w in widths:
        out.append(t[..., start:start + w])
        start += w
    return out


def rmsnorm(x, g):
    xf = x.astype(F32)
    y = xf * lax.rsqrt(jnp.mean(xf * xf, axis=-1, keepdims=True) + EPS)
    return (y * g.astype(F32)).astype(x.dtype)


def l2norm(x):
    return x * lax.rsqrt(jnp.sum(x * x, axis=-1, keepdims=True) + EPS)


def rope_tables(pos, dim):
    inv = ROPE_THETA ** (-jnp.arange(0, dim, 2, dtype=F32) / dim)
    ang = pos.astype(F32)[:, None] * inv[None, :]
    return jnp.cos(ang), jnp.sin(ang)


def apply_rope(x, cos, sin):
    xf = x.astype(F32)
    x1, x2 = jnp.split(xf, 2, axis=-1)
    c = cos[None, :, None, :]
    s = sin[None, :, None, :]
    return jnp.concatenate([x1 * c - x2 * s, x2 * c + x1 * s], axis=-1).astype(x.dtype)


def window_attention(q, k, v, sink):
    Bn, S, Hq, D = q.shape
    Hkv = k.shape[2]
    G = Hq // Hkv
    nb = S // BLOCK
    qb = q.reshape(Bn, nb, BLOCK, Hkv, G, D)
    pad = ((0, 0), (BLOCK, BLOCK), (0, 0), (0, 0))
    kp = jnp.pad(k, pad).reshape(Bn, nb + 2, BLOCK, Hkv, D)
    vp = jnp.pad(v, pad).reshape(Bn, nb + 2, BLOCK, Hkv, D)
    kb = jnp.concatenate([kp[:, :-2], kp[:, 1:-1], kp[:, 2:]], axis=2)
    vb = jnp.concatenate([vp[:, :-2], vp[:, 1:-1], vp[:, 2:]], axis=2)
    s = jnp.einsum('bnqhgd,bnkhd->bnhgqk', qb, kb).astype(F32) * (D ** -0.5)
    qpos = jnp.arange(nb)[:, None] * BLOCK + jnp.arange(BLOCK)[None, :]
    kpos = jnp.arange(nb)[:, None] * BLOCK - BLOCK + jnp.arange(3 * BLOCK)[None, :]
    rel = qpos[:, :, None] - kpos[:, None, :]
    valid = (jnp.abs(rel) <= WINDOW) & (kpos[:, None, :] >= 0) & (kpos[:, None, :] < S)
    s = jnp.where(valid[None, :, None, None], s, -jnp.inf)
    sink_col = jnp.broadcast_to(sink.astype(F32).reshape(Hkv, G)[None, None, :, :, None, None],
                                s.shape[:-1] + (1,))
    p = jax.nn.softmax(jnp.concatenate([s, sink_col], axis=-1), axis=-1)[..., :-1]
    o = jnp.einsum('bnhgqk,bnkhd->bnqhgd', p.astype(v.dtype), vb)
    return o.reshape(Bn, S, Hq, D)


def global_attention(q, k, v):
    Bn, S, Hq, D = q.shape
    Hkv = k.shape[2]
    G = Hq // Hkv
    nb = S // BLOCK
    qb = jnp.moveaxis(q.reshape(Bn, nb, BLOCK, Hkv, G, D), 1, 0)
    scale = D ** -0.5

    def one_block(qi):
        s = jnp.einsum('bqhgd,bkhd->bhgqk', qi, k).astype(F32) * scale
        p = jax.nn.softmax(s, axis=-1)
        return jnp.einsum('bhgqk,bkhd->bqhgd', p.astype(v.dtype), v)

    o = lax.map(one_block, qb)
    return jnp.moveaxis(o, 0, 1).reshape(Bn, S, Hq, D)


def mixer_ab(h, w_in, qn_a, kn_a, sink_a, qn_b, kn_b, w_out, rope_1d, rope_row, rope_col):
    Bn, S, _ = h.shape
    qa, ka, va, qb, kb, vb = split_cols(h @ w_in, AB_IN_WIDTHS)
    qa = qa.reshape(Bn, S, A_Q_HEADS, HEAD_DIM)
    ka = ka.reshape(Bn, S, A_KV_HEADS, HEAD_DIM)
    va = va.reshape(Bn, S, A_KV_HEADS, HEAD_DIM)
    qb = qb.reshape(Bn, S, B_Q_HEADS, HEAD_DIM)
    kb = kb.reshape(Bn, S, B_KV_HEADS, HEAD_DIM)
    vb = vb.reshape(Bn, S, B_KV_HEADS, HEAD_DIM)
    qa = apply_rope(rmsnorm(qa, qn_a), *rope_1d)
    ka = apply_rope(rmsnorm(ka, kn_a), *rope_1d)
    half = HEAD_DIM // 2
    qb = rmsnorm(qb, qn_b)
    kb = rmsnorm(kb, kn_b)
    qb = jnp.concatenate([apply_rope(qb[..., :half], *rope_row), apply_rope(qb[..., half:], *rope_col)], axis=-1)
    kb = jnp.concatenate([apply_rope(kb[..., :half], *rope_row), apply_rope(kb[..., half:], *rope_col)], axis=-1)
    oa = window_attention(qa, ka, va, sink_a)
    ob = global_attention(qb, kb, vb)
    o = jnp.concatenate([oa, ob], axis=2).reshape(Bn, S, AB_OUT)
    return o @ w_out


def centered_conv(x, w):
    pad = (w.shape[0] - 1) // 2
    return lax.conv_general_dilated(x, w[:, None, :], window_strides=(1,), padding=[(pad, pad)],
                                    dimension_numbers=('NWC', 'WIO', 'NWC'),
                                    feature_group_count=x.shape[-1])


def gated_delta_chunked(q, k, v, g, beta):
    Bn, S, H, Dk = q.shape
    Dv = v.shape[-1]
    n = S // C_CHUNK

    def to_chunks(t):
        return t.reshape(Bn, n, C_CHUNK, H, -1).transpose(0, 3, 1, 2, 4)

    q, k, v = to_chunks(q), to_chunks(k), to_chunks(v)
    g = g.reshape(Bn, n, C_CHUNK, H).transpose(0, 3, 1, 2)
    beta = beta.reshape(Bn, n, C_CHUNK, H).transpose(0, 3, 1, 2)
    g = jnp.cumsum(g, axis=-1)
    kb = k * beta[..., None]
    vb = v * beta[..., None]
    incl = jnp.tril(jnp.ones((C_CHUNK, C_CHUNK), bool))
    strict = jnp.tril(jnp.ones((C_CHUNK, C_CHUNK), bool), -1)
    decay = jnp.exp(jnp.where(incl, g[..., :, None] - g[..., None, :], -jnp.inf))
    m = jnp.where(strict, jnp.einsum('bhncd,bhnkd->bhnck', kb, k) * decay, 0.0)
    a = m + jnp.eye(C_CHUNK, dtype=F32)
    rhs = jnp.concatenate([vb, kb * jnp.exp(g)[..., None]], axis=-1)
    sol = lax.linalg.triangular_solve(a, rhs, left_side=True, lower=True)
    u, w = sol[..., :Dv], sol[..., Dv:]
    qk = jnp.where(incl, jnp.einsum('bhncd,bhnkd->bhnck', q, k) * decay, 0.0)
    xs = tuple(jnp.moveaxis(t, 2, 0) for t in (q, k, u, w, g, qk))

    def step(state, inp):
        qi, ki, ui, wi, gi, qki = inp
        v_new = ui - jnp.matmul(wi, state)
        o = jnp.matmul(qi * jnp.exp(gi)[..., None], state) + jnp.matmul(qki, v_new)
        g_last = gi[..., -1]
        state = state * jnp.exp(g_last)[..., None, None] + jnp.einsum(
            'bhcd,bhce->bhde', ki * jnp.exp(g_last[..., None] - gi)[..., None], v_new)
        return state, o

    state0 = jnp.zeros((Bn, H, Dk, Dv), F32)
    _, o = lax.scan(step, state0, xs)
    return o.transpose(1, 0, 3, 2, 4).reshape(Bn, S, H, Dv)


def mixer_c(h, w_in, conv_w, a_log_f, dt_bias_f, a_log_b, dt_bias_b, out_norm, w_out):
    Bn, S, _ = h.shape
    proj = h @ w_in
    qkv = proj[..., :C_CONV_W]
    z, a_f, b_f, a_b, b_b = split_cols(proj[..., C_CONV_W:], C_IN_WIDTHS[3:])
    qkv = jax.nn.silu(centered_conv(qkv, conv_w)).astype(F32)
    q, k, v = split_cols(qkv, (C_QK_W, C_QK_W, C_V_W))
    q = l2norm(q.reshape(Bn, S, C_HEADS, C_DK)) * (C_DK ** -0.5)
    k = l2norm(k.reshape(Bn, S, C_HEADS, C_DK))
    v = v.reshape(Bn, S, C_HEADS, C_DV)
    g_f = -jnp.exp(a_log_f.astype(F32)) * jax.nn.softplus(a_f.astype(F32) + dt_bias_f.astype(F32))
    g_b = -jnp.exp(a_log_b.astype(F32)) * jax.nn.softplus(a_b.astype(F32) + dt_bias_b.astype(F32))
    beta_f = jax.nn.sigmoid(b_f.astype(F32))
    beta_b = jax.nn.sigmoid(b_b.astype(F32))
    o_f = gated_delta_chunked(q, k, v, g_f, beta_f)
    o_b = gated_delta_chunked(q[:, ::-1], k[:, ::-1], v[:, ::-1], g_b[:, ::-1], beta_b[:, ::-1])[:, ::-1]
    o = o_f + o_b
    o = rmsnorm(o, out_norm) * jax.nn.silu(z.astype(F32).reshape(Bn, S, C_HEADS, C_DV))
    return o.reshape(Bn, S, C_V_W).astype(h.dtype) @ w_out


def swiglu(h, w_gate, w_up, w_down):
    return (jax.nn.silu(h @ w_gate) * (h @ w_up)) @ w_down


def moe_swiglu(h, w_router, w_gate, w_up, w_down):
    logits = (h @ w_router).astype(F32)
    top_v, top_i = lax.top_k(logits, TOP_K)
    gates = jax.nn.softmax(top_v, axis=-1)
    combine = jnp.sum(jax.nn.one_hot(top_i, N_EXPERTS, dtype=F32) * gates[..., None], axis=-2)
    y = jnp.zeros_like(h)
    for e in range(N_EXPERTS):
        y = y + combine[..., e:e + 1].astype(h.dtype) * swiglu(h, w_gate[e], w_up[e], w_down[e])
    return y


def setup_inputs(seed: int = 0) -> dict:
    key = jax.random.key(seed)
    ks = iter(jax.random.split(key, 64))

    def nrm(shape, scale):
        return jax.random.normal(next(ks), shape, F32) * scale

    def gain(shape):
        return 1.0 + nrm(shape, 0.02)

    def dt_bias(shape):
        dt = jnp.exp(jax.random.uniform(next(ks), shape, F32, minval=np.log(1e-3), maxval=np.log(1e-1)))
        return dt + jnp.log(-jnp.expm1(-dt))

    def a_log(shape):
        return jnp.log(jax.random.uniform(next(ks), shape, F32, minval=1.0, maxval=16.0))

    d = D_MODEL
    return {
        "x": nrm((BATCH, SEQ, d), 1.0),
        "ab_norm": gain((N_EVEN, d)),
        "ab_w_in": nrm((N_EVEN, d, AB_IN), d ** -0.5),
        "ab_q_norm_a": gain((N_EVEN, HEAD_DIM)),
        "ab_k_norm_a": gain((N_EVEN, HEAD_DIM)),
        "ab_sink_a": nrm((N_EVEN, A_Q_HEADS), 0.5),
        "ab_q_norm_b": gain((N_EVEN, HEAD_DIM)),
        "ab_k_norm_b": gain((N_EVEN, HEAD_DIM)),
        "ab_w_out": nrm((N_EVEN, AB_OUT, d), AB_OUT ** -0.5),
        "ffn_norm": gain((N_EVEN, d)),
        "ffn_w_gate": nrm((N_EVEN, d, D_FF), d ** -0.5),
        "ffn_w_up": nrm((N_EVEN, d, D_FF), d ** -0.5),
        "ffn_w_down": nrm((N_EVEN, D_FF, d), D_FF ** -0.5),
        "c_norm": gain((N_ODD, d)),
        "c_w_in": nrm((N_ODD, d, C_IN), d ** -0.5),
        "c_conv": nrm((N_ODD, C_CONV, C_CONV_W), C_CONV ** -0.5),
        "c_a_log_fwd": a_log((N_ODD, C_HEADS)),
        "c_dt_bias_fwd": dt_bias((N_ODD, C_HEADS)),
        "c_a_log_bwd": a_log((N_ODD, C_HEADS)),
        "c_dt_bias_bwd": dt_bias((N_ODD, C_HEADS)),
        "c_out_norm": gain((N_ODD, C_DV)),
        "c_w_out": nrm((N_ODD, C_V_W, d), C_V_W ** -0.5),
        "moe_norm": gain((N_ODD, d)),
        "moe_w_router": nrm((N_ODD, d, N_EXPERTS), d ** -0.5),
        "moe_w_gate": nrm((N_ODD, N_EXPERTS, d, D_FF_EXPERT), d ** -0.5),
        "moe_w_up": nrm((N_ODD, N_EXPERTS, d, D_FF_EXPERT), d ** -0.5),
        "moe_w_down": nrm((N_ODD, N_EXPERTS, D_FF_EXPERT, d), D_FF_EXPERT ** -0.5),
    }


def reference(x, ab_norm, ab_w_in, ab_q_norm_a, ab_k_norm_a, ab_sink_a, ab_q_norm_b, ab_k_norm_b,
              ab_w_out, ffn_norm, ffn_w_gate, ffn_w_up, ffn_w_down, c_norm, c_w_in, c_conv,
              c_a_log_fwd, c_dt_bias_fwd, c_a_log_bwd, c_dt_bias_bwd, c_out_norm, c_w_out,
              moe_norm, moe_w_router, moe_w_gate, moe_w_up, moe_w_down):
    S = x.shape[1]
    ROWS = S // GRID_W
    t = jnp.arange(S)
    row = jnp.repeat(jnp.arange(ROWS), GRID_W)
    col = jnp.tile(jnp.arange(GRID_W), ROWS)
    rope_1d = rope_tables(t, HEAD_DIM)
    rope_row = rope_tables(row, HEAD_DIM // 2)
    rope_col = rope_tables(col, HEAD_DIM // 2)
    for layer in range(DEPTH):
        i = layer // 2
        if layer % 2 == 0:
            x = x + mixer_ab(rmsnorm(x, ab_norm[i]), ab_w_in[i], ab_q_norm_a[i], ab_k_norm_a[i],
                             ab_sink_a[i], ab_q_norm_b[i], ab_k_norm_b[i], ab_w_out[i],
                             rope_1d, rope_row, rope_col)
            x = x + swiglu(rmsnorm(x, ffn_norm[i]), ffn_w_gate[i], ffn_w_up[i], ffn_w_down[i])
        else:
            x = x + mixer_c(rmsnorm(x, c_norm[i]), c_w_in[i], c_conv[i], c_a_log_fwd[i], c_dt_bias_fwd[i],
                            c_a_log_bwd[i], c_dt_bias_bwd[i], c_out_norm[i], c_w_out[i])
            x = x + moe_swiglu(rmsnorm(x, moe_norm[i]), moe_w_router[i], moe_w_gate[i], moe_w_up[i],
                               moe_w_down[i])
    return x
```

```cpp
#include <hip/hip_runtime.h>
#include <cstdio>
#include <cstdint>
#include <cmath>
namespace pg8 {
#define PG8_LAS __attribute__((address_space(3)))
typedef unsigned short bf16_t;
typedef short bf16x8 __attribute__((ext_vector_type(8)));
typedef float f32x4 __attribute__((ext_vector_type(4)));
typedef unsigned u32x4 __attribute__((ext_vector_type(4)));
constexpr int BM = 256, BK = 64, HALF = 128, HTB = HALF * BK * 2  , STAGE_BYTES = 8 * HTB, NXCD = 8, WGM = 8;

__host__ __device__ __forceinline__ int lds_byte(int r, int c) { const int st = (r >> 4) * 2 + (c >> 5), rr = r & 15, cc = c & 31, ob = rr * 64 + cc * 2; return st * 1024 + (ob ^ (((ob >> 9) & 1) << 5)); }
__host__ __device__ __forceinline__ void stage_rc(int b, int& R, int& C) { const int st = b / 1024, sb = b % 1024, swz = sb ^ (((sb >> 9) & 1) << 5); R = (st >> 1) * 16 + swz / 64; C = (st & 1) * 32 + (swz % 64) / 2; }
__host__ __device__ __forceinline__ int perm32(int rho) { const int n = rho >> 4, i = rho & 15; return 8 * (i >> 2) + 4 * n + (i & 3); }

struct Unit { int pm, pn, e; };
struct Gemm { const bf16_t* A; const bf16_t* Bt; int M, N, K; size_t estride; };

struct StaticOrder {
    int nM, nN, nwg, G, c;
    __host__ __device__ void init(int M, int N, int G_, int c_) { nM = M / BM; nN = N / BM; nwg = nM * nN; G = G_; c = c_; }
    __host__ __device__ bool next(int i, Unit& u) const {
        const long L = (long)i * G + c; if (L >= nwg) return false;
        int wgid = (int)L; { const int q = nwg / NXCD, r = nwg % NXCD, xcd = wgid % NXCD, off = wgid / NXCD; wgid = (xcd < r ? xcd * (q + 1) : r * (q + 1) + (xcd - r) * q) + off; }
        const int nig = WGM * nN, gid = wgid / nig, fm = gid * WGM, gsz = (nM - fm) < WGM ? (nM - fm) : WGM;
        u.pm = fm + ((wgid % nig) % gsz); u.pn = (wgid % nig) / gsz; u.e = 0; return true;
    }
    __device__ __forceinline__ void a_ready(const Unit&) const {}
    __device__ __forceinline__ void done(const Unit&) const {}
};

__device__ __forceinline__ unsigned cvt_pk_bf16(float lo, float hi) { unsigned r; asm volatile("v_cvt_pk_bf16_f32 %0, %1, %2" : "=v"(r) : "v"(lo), "v"(hi)); return r; }
typedef float f32x2 __attribute__((ext_vector_type(2)));
__device__ __forceinline__ f32x2 gelu_pk(f32x2 v) {
    const f32x2 av = __builtin_elementwise_abs(v), d = av * 0.2316418882f + 1.0f;
    f32x2 t; t.x = __builtin_amdgcn_rcpf(d.x); t.y = __builtin_amdgcn_rcpf(d.y);
    f32x2 q = t * 0.5307027145f + (-0.7265760135f); q = q * t + 0.7107068705f; q = q * t + (-0.142248368f); q = q * t + 0.127414796f; q = q * t;
    const f32x2 s = (v * v) * (-0.72134752044f);
    f32x2 e; e.x = __builtin_amdgcn_exp2f(s.x); e.y = __builtin_amdgcn_exp2f(s.y);
    const f32x2 m = v * (q * e), r = v - m;
    f32x2 o; o.x = v.x < 0.f ? m.x : r.x; o.y = v.y < 0.f ? m.y : r.y; return o;
}

template <int ACT  > struct EpiBf16 {
    static constexpr bool PERM = true, AFTER_DRAIN = false; static_assert(ACT == 0 || ACT == 1, "EpiBf16: ACT is 0 (none) or 1 (gelu_pk)");
    bf16_t* O; int ldc; const float* bias; int split_cols; size_t split_stride; float scale0;
    __device__ __forceinline__ void operator()(const f32x4 (&acc)[2][2][4][2], const Unit& u, int wr, int wc, int fr, int fq) const {
        const int row0 = u.pm * BM + wr * 64 + fr; int colt = u.pn * BM; bf16_t* base = O;
        float sc = 1.f; if (split_cols) { const int t = colt / split_cols; base += (size_t)t * split_stride; colt -= t * split_cols; if (t == 0) sc = scale0; }
        const int col0 = colt + wc * 32 + 8 * fq, bcol0 = u.pn * BM + wc * 32 + 8 * fq;
        f32x4 bv[2][2];
#pragma unroll
        for (int bj = 0; bj < 2; ++bj)
#pragma unroll
            for (int n = 0; n < 2; ++n) bv[bj][n] = bias ? *(const f32x4*)(bias + bcol0 + bj * HALF + 4 * n) : (f32x4){0.f, 0.f, 0.f, 0.f};
#pragma unroll
        for (int ai = 0; ai < 2; ++ai)
#pragma unroll
            for (int m = 0; m < 4; ++m) { bf16_t* rowp = base + (size_t)(row0 + ai * HALF + m * 16) * ldc + col0;
#pragma unroll
                for (int bj = 0; bj < 2; ++bj) { f32x4 v0 = acc[ai][bj][m][0] + bv[bj][0], v1 = acc[ai][bj][m][1] + bv[bj][1];
                    if (ACT == 1) { f32x2 a = gelu_pk((f32x2){v0[0], v0[1]}), b = gelu_pk((f32x2){v0[2], v0[3]}), c = gelu_pk((f32x2){v1[0], v1[1]}), d = gelu_pk((f32x2){v1[2], v1[3]});
                        v0 = (f32x4){a.x, a.y, b.x, b.y}; v1 = (f32x4){c.x, c.y, d.x, d.y}; }
                    v0 = v0 * sc; v1 = v1 * sc; u32x4 w; w.x = cvt_pk_bf16(v0[0], v0[1]); w.y = cvt_pk_bf16(v0[2], v0[3]); w.z = cvt_pk_bf16(v1[0], v1[1]); w.w = cvt_pk_bf16(v1[2], v1[3]);
                    *(u32x4*)(rowp + bj * HALF) = w; } }
    }
};

__device__ __forceinline__ float silu_f(float x) { return x * __builtin_amdgcn_rcpf(1.0f + __builtin_amdgcn_exp2f(-1.4426950408889634f * x)); }
struct EpiResF32 {
    static constexpr bool PERM = false, AFTER_DRAIN = false;
    const float* base; float* out; int ldc;
    __device__ __forceinline__ void operator()(const f32x4 (&acc)[2][2][4][2], const Unit& u, int wr, int wc, int fr, int fq) const {
        const int col0 = u.pn * BM + wc * 32 + 4 * fq;
#pragma unroll
        for (int ai = 0; ai < 2; ++ai)
#pragma unroll
            for (int m = 0; m < 4; ++m) { const size_t off = (size_t)(u.pm * BM + ai * HALF + wr * 64 + m * 16 + fr) * ldc + col0;
#pragma unroll
                for (int bj = 0; bj < 2; ++bj)
#pragma unroll
                    for (int n = 0; n < 2; ++n) { const f32x4 bs = *(const f32x4*)(base + off + bj * HALF + n * 16); *(f32x4*)(out + off + bj * HALF + n * 16) = bs + acc[ai][bj][m][n]; }
                if (m & 1) asm volatile("" ::: "memory"); }
    }
};
struct EpiF32 {
    static constexpr bool PERM = false, AFTER_DRAIN = false;
    float* out; int ldc;
    __device__ __forceinline__ void operator()(const f32x4 (&acc)[2][2][4][2], const Unit& u, int wr, int wc, int fr, int fq) const {
        const int col0 = u.pn * BM + wc * 32 + 4 * fq;
#pragma unroll
        for (int ai = 0; ai < 2; ++ai)
#pragma unroll
            for (int m = 0; m < 4; ++m) { const size_t off = (size_t)(u.pm * BM + ai * HALF + wr * 64 + m * 16 + fr) * ldc + col0;
#pragma unroll
                for (int bj = 0; bj < 2; ++bj)
#pragma unroll
                    for (int n = 0; n < 2; ++n) *(f32x4*)(out + off + bj * HALF + n * 16) = acc[ai][bj][m][n]; }
    }
};
struct EpiSwiGLU {
    static constexpr bool PERM = true, AFTER_DRAIN = false;
    bf16_t* O; int ldc;
    __device__ __forceinline__ void operator()(const f32x4 (&acc)[2][2][4][2], const Unit& u, int wr, int wc, int fr, int fq) const {
        const int col0 = u.pn * HALF + wc * 32 + 8 * fq;
#pragma unroll
        for (int ai = 0; ai < 2; ++ai)
#pragma unroll
            for (int m = 0; m < 4; ++m) { bf16_t* rowp = O + (size_t)(u.pm * BM + ai * HALF + wr * 64 + m * 16 + fr) * ldc + col0;
                const f32x4 g0 = acc[ai][0][m][0], g1 = acc[ai][0][m][1], u0 = acc[ai][1][m][0], u1 = acc[ai][1][m][1];
                u32x4 w; w.x = cvt_pk_bf16(silu_f(g0[0]) * u0[0], silu_f(g0[1]) * u0[1]); w.y = cvt_pk_bf16(silu_f(g0[2]) * u0[2], silu_f(g0[3]) * u0[3]);
                w.z = cvt_pk_bf16(silu_f(g1[0]) * u1[0], silu_f(g1[1]) * u1[1]); w.w = cvt_pk_bf16(silu_f(g1[2]) * u1[2], silu_f(g1[3]) * u1[3]);
                *(u32x4*)rowp = w; }
    }
};
struct EpiQKV {
    static constexpr bool PERM = true, AFTER_DRAIN = false;
    bf16_t* O; const float* gains;
    const float* tab;
    float qscale, eps;
    __device__ __forceinline__ void operator()(const f32x4 (&acc)[2][2][4][2], const Unit& u, int wr, int wc, int fr, int fq) const {
        const int tile = u.pn; int gsel = 0; bool ax = false; float sc = 1.f; bool plain = false;
        if (tile < 2) { gsel = 0; ax = false; sc = qscale; } else if (tile < 4) { gsel = 2; ax = true; sc = qscale; } else if (tile == 4) { if (wc < 2) { gsel = 1; ax = false; } else { gsel = 3; ax = true; } } else plain = true;
        bf16_t* obase = O + tile * 256 + wc * 64 + 8 * fq;
        if (plain) {
#pragma unroll
            for (int ai = 0; ai < 2; ++ai)
#pragma unroll
                for (int m = 0; m < 4; ++m) { bf16_t* rowp = obase + (size_t)(u.pm * BM + ai * HALF + wr * 64 + m * 16 + fr) * 1536;
#pragma unroll
                    for (int bj = 0; bj < 2; ++bj) { const f32x4 v0 = acc[ai][bj][m][0], v1 = acc[ai][bj][m][1]; u32x4 w; w.x = cvt_pk_bf16(v0[0], v0[1]); w.y = cvt_pk_bf16(v0[2], v0[3]); w.z = cvt_pk_bf16(v1[0], v1[1]); w.w = cvt_pk_bf16(v1[2], v1[3]);
                        *(u32x4*)(rowp + 32 * bj) = w; } }
            return;
        }
        const float* gp = gains + gsel * 64 + 8 * fq; const float* tabp = tab + (ax ? 2 * 8192 * 32 : 0);
        f32x4 ga[2][2];
#pragma unroll
        for (int bj = 0; bj < 2; ++bj)
#pragma unroll
            for (int n = 0; n < 2; ++n) ga[bj][n] = *(const f32x4*)(gp + 32 * bj + 4 * n);
#pragma unroll
        for (int ai = 0; ai < 2; ++ai)
#pragma unroll
            for (int m = 0; m < 4; ++m) {
                const int row = u.pm * BM + ai * HALF + wr * 64 + m * 16 + fr, t = row & 8191;
                f32x4 x1[2], x2[2]; x1[0] = acc[ai][0][m][0]; x1[1] = acc[ai][0][m][1]; x2[0] = acc[ai][1][m][0]; x2[1] = acc[ai][1][m][1];
                float ss = 0.f;
#pragma unroll
                for (int n = 0; n < 2; ++n)
#pragma unroll
                    for (int j = 0; j < 4; ++j) ss += x1[n][j] * x1[n][j] + x2[n][j] * x2[n][j];
                ss += __shfl_xor(ss, 16); ss += __shfl_xor(ss, 32);
                const float r = 1.0f / sqrtf(ss * (1.0f / 64.0f) + eps);
                const float* cp = tabp + (size_t)t * 32 + 8 * fq; const float* sp = cp + 8192 * 32;
                u32x4 w1, w2;
#pragma unroll
                for (int n = 0; n < 2; ++n) { const f32x4 c = *(const f32x4*)(cp + 4 * n), s = *(const f32x4*)(sp + 4 * n);
                    const f32x4 y1 = x1[n] * r * ga[0][n], y2 = x2[n] * r * ga[1][n];
                    const f32x4 o1 = (y1 * c - y2 * s) * sc, o2 = (y2 * c + y1 * s) * sc;
                    w1[2 * n] = cvt_pk_bf16(o1[0], o1[1]); w1[2 * n + 1] = cvt_pk_bf16(o1[2], o1[3]); w2[2 * n] = cvt_pk_bf16(o2[0], o2[1]); w2[2 * n + 1] = cvt_pk_bf16(o2[2], o2[3]); }
                bf16_t* rowp = obase + (size_t)row * 1536;
                *(u32x4*)rowp = w1; *(u32x4*)(rowp + 32) = w2;
            }
    }
};
struct MoeOrder {
    int nM, nN, nwg, G, c; int t0[9];
    __device__ void init(const int* meta, int N, int G_, int c_) {
#pragma unroll
        for (int e = 0; e < 9; ++e) t0[e] = __builtin_amdgcn_readfirstlane(meta[e]) >> 8;
        nM = t0[8]; nN = N / BM; nwg = nM * nN; G = G_; c = c_; }
    __device__ bool next(int i, Unit& u) const {
        const long L = (long)i * G + c; if (L >= nwg) return false;
        int wgid = (int)L; { const int q = nwg / NXCD, r = nwg % NXCD, xcd = wgid % NXCD, off = wgid / NXCD; wgid = (xcd < r ? xcd * (q + 1) : r * (q + 1) + (xcd - r) * q) + off; }
        const int nig = WGM * nN, gid = wgid / nig, fm = gid * WGM, gsz = (nM - fm) < WGM ? (nM - fm) : WGM;
        u.pm = fm + ((wgid % nig) % gsz); u.pn = (wgid % nig) / gsz; int e = 0;
#pragma unroll
        for (int k = 1; k < 8; ++k) e += (u.pm >= t0[k]) ? 1 : 0;
        u.e = e; return true;
    }
    __device__ __forceinline__ void a_ready(const Unit&) const {}
    __device__ __forceinline__ void done(const Unit&) const {}
};
template <class Epi, class Sched, bool ALIGN_EPI = false, bool SP2 = false>
__device__ __forceinline__ void gemm_phase(PG8_LAS unsigned char* lds, const Gemm g, const Sched& S, const Epi& E) {
    const int tid = threadIdx.x, wid = __builtin_amdgcn_readfirstlane(tid >> 6), lane = tid & 63, wr = wid >> 2, wc = wid & 3, fr = lane & 15, fq = lane >> 4;
    const int K = g.K, nt = K / BK;
    unsigned voffA[2], voffB[2];
#pragma unroll
    for (int i = 0; i < 2; ++i) { int R, C; stage_rc(tid * 16 + i * 8192, R, C); const int Rb = Epi::PERM ? ((R & ~31) + perm32(R & 31)) : R;
        voffA[i] = (unsigned)(R * K + C) * 2u; voffB[i] = (unsigned)(Rb * K + C) * 2u; }
    const size_t kstep = (size_t)(BK * 2);
    const size_t hstep = (size_t)HALF * K * 2;
    const size_t tstep = 2 * hstep;
    const unsigned ldsw = (unsigned)wid * 1024u;
    const int aoff = lds_byte(wr * 64 + fr, fq * 8), boff = lds_byte(wc * 32 + fr, fq * 8);
#define PG8_SA(b, h) (((b) * 2 + (h)) * HTB)
#define PG8_SB(b, h) ((4 + (b) * 2 + (h)) * HTB)
#define PG8_STAGE(bufoff, gbase, voff) do { _Pragma("unroll") for (int _i = 0; _i < 2; ++_i) \
        __builtin_amdgcn_global_load_lds((const unsigned*)((const char*)(gbase) + (voff)[_i]), (PG8_LAS unsigned*)(lds + (bufoff) + ldsw + _i * 8192), 16, 0, 0); } while (0)
#define PG8_LDA(dst, b, h) do { _Pragma("unroll") for (int m = 0; m < 4; ++m) _Pragma("unroll") for (int k = 0; k < 2; ++k) dst[m][k] = *(const PG8_LAS bf16x8*)(lds + PG8_SA(b, h) + aoff + m * 2048 + k * 1024); } while (0)
#define PG8_LDB(dst, b, h) do { _Pragma("unroll") for (int n = 0; n < 2; ++n) _Pragma("unroll") for (int k = 0; k < 2; ++k) dst[n][k] = *(const PG8_LAS bf16x8*)(lds + PG8_SB(b, h) + boff + n * 2048 + k * 1024); } while (0)
#define PG8_MMA(ai, bj, At, Bt) do { __builtin_amdgcn_s_setprio(1); _Pragma("unroll") for (int m = 0; m < 4; ++m) _Pragma("unroll") for (int n = 0; n < 2; ++n) _Pragma("unroll") for (int k = 0; k < 2; ++k) \
        acc[ai][bj][m][n] = __builtin_amdgcn_mfma_f32_16x16x32_bf16(Bt[n][k], At[m][k], acc[ai][bj][m][n], 0, 0, 0); __builtin_amdgcn_s_setprio(0); } while (0)
#define PG8_WAIT_V(n) asm volatile("s_waitcnt vmcnt(" #n ")" ::: "memory")
#define PG8_WAIT_L(n) asm volatile("s_waitcnt lgkmcnt(" #n ")" ::: "memory")
#define PG8_BAR __builtin_amdgcn_s_barrier()
#define PG8_SCHED __builtin_amdgcn_sched_barrier(0)
    Unit cur, nxt; int ui = 0;
    if (!S.next(0, cur)) return;
    f32x4 acc[2][2][4][2];
#pragma unroll
    for (int a = 0; a < 2; ++a)
#pragma unroll
        for (int b = 0; b < 2; ++b)
#pragma unroll
            for (int m = 0; m < 4; ++m)
#pragma unroll
                for (int n = 0; n < 2; ++n) acc[a][b][m][n] = (f32x4){0.f, 0.f, 0.f, 0.f};
    bf16x8 At[4][2], B0[2][2], B1[2][2];
    const char* cA = (const char*)g.A + (size_t)cur.pm * tstep; const char* cB = (const char*)g.Bt + (size_t)cur.e * g.estride + (size_t)cur.pn * tstep;
    S.a_ready(cur);
    if constexpr (SP2) {
        PG8_STAGE(PG8_SB(0, 0), cB, voffB); PG8_STAGE(PG8_SB(0, 1), cB + hstep, voffB); PG8_STAGE(PG8_SA(0, 0), cA, voffA); PG8_STAGE(PG8_SA(0, 1), cA + hstep, voffA);
        if (wr == 1) PG8_BAR;
        PG8_WAIT_V(2); PG8_BAR;
        PG8_STAGE(PG8_SB(1, 0), cB + kstep, voffB); PG8_STAGE(PG8_SA(1, 0), cA + kstep, voffA); PG8_STAGE(PG8_SB(1, 1), cB + hstep + kstep, voffB);
        PG8_WAIT_V(6); PG8_BAR;
    } else {
        PG8_STAGE(PG8_SB(0, 0), cB, voffB); PG8_STAGE(PG8_SA(0, 0), cA, voffA); PG8_STAGE(PG8_SB(0, 1), cB + hstep, voffB); PG8_STAGE(PG8_SA(0, 1), cA + hstep, voffA);
        if (wr == 1) PG8_BAR;
        PG8_WAIT_V(4); PG8_BAR;
        PG8_STAGE(PG8_SB(1, 0), cB + kstep, voffB); PG8_STAGE(PG8_SA(1, 0), cA + kstep, voffA); PG8_STAGE(PG8_SB(1, 1), cB + hstep + kstep, voffB);
        PG8_WAIT_V(6); PG8_BAR;
    }
    for (;;) {
        const bool has_next = S.next(ui + 1, nxt);
        const char* nA = has_next ? (const char*)g.A + (size_t)nxt.pm * tstep : cA; const char* nB = has_next ? (const char*)g.Bt + (size_t)nxt.e * g.estride + (size_t)nxt.pn * tstep : cB;
        for (int t = 0; t < nt; t += 2) {
            const bool last = (t == nt - 2);
            const char* a1 = cA + (size_t)(t + 1) * kstep;
            const char* a2 = last ? nA : cA + (size_t)(t + 2) * kstep; const char* b2 = last ? nB : cB + (size_t)(t + 2) * kstep;
            const char* a3 = a2 + kstep; const char* b3 = b2 + kstep;
            if (last && has_next) S.a_ready(nxt);
            if constexpr (SP2) {
            PG8_LDB(B0, 0, 0); PG8_LDB(B1, 0, 1); PG8_SCHED; PG8_LDA(At, 0, 0); PG8_STAGE(PG8_SA(1, 1), a1 + hstep, voffA);
            PG8_WAIT_V(8); PG8_WAIT_L(0); PG8_BAR; PG8_MMA(0, 0, At, B0); PG8_MMA(0, 1, At, B1); PG8_BAR; PG8_SCHED;
            PG8_LDA(At, 0, 1); PG8_STAGE(PG8_SB(0, 0), b2, voffB); PG8_STAGE(PG8_SB(0, 1), b2 + hstep, voffB); PG8_STAGE(PG8_SA(0, 0), a2, voffA);
            PG8_WAIT_V(8); PG8_WAIT_L(0); PG8_BAR; PG8_MMA(1, 0, At, B0); PG8_MMA(1, 1, At, B1); PG8_BAR; PG8_SCHED;
            PG8_LDB(B0, 1, 0); PG8_LDB(B1, 1, 1); PG8_SCHED; PG8_LDA(At, 1, 0); PG8_STAGE(PG8_SA(0, 1), a2 + hstep, voffA);
            PG8_WAIT_V(8); PG8_WAIT_L(0); PG8_BAR; PG8_MMA(0, 0, At, B0); PG8_MMA(0, 1, At, B1); PG8_BAR; PG8_SCHED;
            PG8_LDA(At, 1, 1); PG8_STAGE(PG8_SB(1, 0), b3, voffB); PG8_STAGE(PG8_SB(1, 1), b3 + hstep, voffB); PG8_STAGE(PG8_SA(1, 0), a3, voffA);
            PG8_WAIT_V(8); PG8_WAIT_L(0); PG8_BAR; PG8_MMA(1, 0, At, B0); PG8_MMA(1, 1, At, B1); PG8_BAR; PG8_SCHED;
            } else {
            PG8_LDB(B0, 0, 0); PG8_SCHED; PG8_LDA(At, 0, 0); PG8_STAGE(PG8_SA(1, 1), a1 + hstep, voffA);
            PG8_WAIT_L(8); PG8_BAR; PG8_WAIT_L(0); PG8_MMA(0, 0, At, B0); PG8_BAR; PG8_SCHED;
            PG8_LDB(B1, 0, 1); PG8_STAGE(PG8_SB(0, 0), b2, voffB);
            PG8_BAR; PG8_WAIT_L(0); PG8_MMA(0, 1, At, B1); PG8_BAR;
            PG8_LDA(At, 0, 1); PG8_STAGE(PG8_SA(0, 0), a2, voffA);
            PG8_BAR; PG8_WAIT_L(0); PG8_MMA(1, 0, At, B0); PG8_BAR; PG8_SCHED;
            PG8_STAGE(PG8_SB(0, 1), b2 + hstep, voffB);
            PG8_WAIT_V(6); PG8_BAR; PG8_MMA(1, 1, At, B1); PG8_BAR;
            PG8_LDB(B0, 1, 0); PG8_SCHED; PG8_LDA(At, 1, 0); PG8_STAGE(PG8_SA(0, 1), a2 + hstep, voffA);
            PG8_WAIT_L(8); PG8_BAR; PG8_WAIT_L(0); PG8_MMA(0, 0, At, B0); PG8_BAR; PG8_SCHED;
            PG8_LDB(B1, 1, 1); PG8_STAGE(PG8_SB(1, 0), b3, voffB);
            PG8_BAR; PG8_WAIT_L(0); PG8_MMA(0, 1, At, B1); PG8_BAR;
            PG8_LDA(At, 1, 1); PG8_STAGE(PG8_SA(1, 0), a3, voffA);
            PG8_BAR; PG8_WAIT_L(0); PG8_MMA(1, 0, At, B0); PG8_BAR; PG8_SCHED;
            PG8_STAGE(PG8_SB(1, 1), b3 + hstep, voffB);
            PG8_WAIT_V(6); PG8_BAR; PG8_MMA(1, 1, At, B1); PG8_BAR;
            }
        }
        if constexpr (ALIGN_EPI) { if (wr == 0) PG8_BAR; }
        if constexpr (!Epi::AFTER_DRAIN) { E(acc, cur, wr, wc, fr, fq); S.done(cur); }
        if (!has_next) break;
#pragma unroll
        for (int a = 0; a < 2; ++a)
#pragma unroll
            for (int b = 0; b < 2; ++b)
#pragma unroll
                for (int m = 0; m < 4; ++m)
#pragma unroll
                    for (int n = 0; n < 2; ++n) acc[a][b][m][n] = (f32x4){0.f, 0.f, 0.f, 0.f};
        cur = nxt; cA = nA; cB = nB; ++ui;
        if constexpr (ALIGN_EPI) { if (wr == 1) PG8_BAR; }
    }
    PG8_WAIT_V(0);
    if constexpr (!ALIGN_EPI) { if (wr == 0) PG8_BAR; }
    PG8_BAR;
    if constexpr (Epi::AFTER_DRAIN) { E.fused(acc, cur, wr, wc, fr, fq, lds, wid, lane); S.done(cur); }
#undef PG8_SA
#undef PG8_SB
#undef PG8_STAGE
#undef PG8_LDA
#undef PG8_LDB
#undef PG8_MMA
#undef PG8_WAIT_V
#undef PG8_WAIT_L
#undef PG8_BAR
#undef PG8_SCHED
}
}

#ifndef PG8_SP2
#define PG8_SP2 true
#endif
#ifndef PG8_ALIGN
#define PG8_ALIGN true
#endif
#define GAS __attribute__((address_space(1)))
#define LAS __attribute__((address_space(3)))
typedef unsigned short bf16;
typedef unsigned v4u __attribute__((ext_vector_type(4)));
typedef float f32x4 __attribute__((ext_vector_type(4)));
typedef short bf16x8 __attribute__((ext_vector_type(8)));
typedef GAS unsigned gu32;
typedef GAS unsigned long long gu64;
#define RLX_AGENT __ATOMIC_RELAXED, __HIP_MEMORY_SCOPE_AGENT
#define LDS_WAIT() asm volatile("s_waitcnt lgkmcnt(0)" ::: "memory")
#define VM_WAIT() asm volatile("s_waitcnt vmcnt(0)" ::: "memory")
__device__ __forceinline__ unsigned long long rt() { return __builtin_amdgcn_s_memrealtime(); }
__device__ __forceinline__ unsigned f2bf(float f) { unsigned u = __builtin_bit_cast(unsigned, f); return (u + 0x7fffu + ((u >> 16) & 1u)) >> 16; }
__device__ __forceinline__ unsigned pk2(float lo, float hi) { return f2bf(lo) | (f2bf(hi) << 16); }

#define XB_TMO      128
#define XB_XCNT(j)  (256  + 64 * (j))
#define XB_XSUB(j)  (1280 + 64 * (j))
#define XB_XGEN(j)  (2304 + 64 * (j))
#define XB_TOP      3328
#define XB_TOPGEN   3392
#define XCD_BAR_WORDS 3456
#define XB_SPIN_CAP (1u << 18)

__device__ __forceinline__ unsigned xb_ld(unsigned* p)              { return __hip_atomic_load(p, __ATOMIC_RELAXED, __HIP_MEMORY_SCOPE_AGENT); }
__device__ __forceinline__ unsigned xb_add(unsigned* p, unsigned v) { return __hip_atomic_fetch_add(p, v, __ATOMIC_RELAXED, __HIP_MEMORY_SCOPE_AGENT); }
__device__ __forceinline__ unsigned xb_xcc_id() { return (unsigned)__builtin_amdgcn_s_getreg((3 << 11) | 20) & 0xFu; }
#define XB_SPIN(cond, bar) do { unsigned _sp = 0; while (cond) { __builtin_amdgcn_s_sleep(1); \
    if ((++_sp & 255u) == 0u) { if (xb_ld(&(bar)[XB_TMO])) break; if (_sp > XB_SPIN_CAP) { atomicAdd(&(bar)[XB_TMO], 1u); break; } } } } while (0)

struct XcdBarrier {
    unsigned* bar; unsigned x;
    volatile LAS unsigned* st;
};

__device__ __forceinline__ XcdBarrier xcd_barrier_post(unsigned* bar, volatile LAS unsigned* st) {
    XcdBarrier b; b.bar = bar; b.x = xb_xcc_id(); b.st = st;
    if (threadIdx.x == 0) (void)xb_add(&bar[XB_XCNT(b.x)], 1u);
    return b;
}
__device__ __forceinline__ void xcd_barrier_complete(unsigned* bar, unsigned x, unsigned& nloc, unsigned& nx) {
    const unsigned G = gridDim.x * gridDim.y * gridDim.z;
    unsigned sum, cnt, mine, sp = 0u;
    for (;;) {
        sum = 0u; cnt = 0u; mine = 0u;
#pragma unroll
        for (unsigned j = 0; j < 16; ++j) { const unsigned c = xb_ld(&bar[XB_XCNT(j)]); sum += c; cnt += (c > 0u) ? 1u : 0u; mine = (j == x) ? c : mine; }
        if (sum == G) break;
        __builtin_amdgcn_s_sleep(1);
        if ((++sp & 255u) == 0u) { if (xb_ld(&bar[XB_TMO])) break; if (sp > XB_SPIN_CAP) { atomicAdd(&bar[XB_TMO], 1u); break; } }
    }
    nloc = mine > 0u ? mine : 1u; nx = cnt > 0u ? cnt : 1u;
}

__device__ __forceinline__ void xcd_barrier(const XcdBarrier& b) {
    asm volatile("s_waitcnt vmcnt(0)" ::: "memory");
    __syncthreads();
    if (threadIdx.x == 0) {
        unsigned* bar = b.bar;
        __builtin_amdgcn_s_waitcnt(0);
        unsigned nloc = b.st[0], nx = b.st[1];
        if (nloc == 0u) { xcd_barrier_complete(bar, b.x, nloc, nx); b.st[0] = nloc; b.st[1] = nx; }
        const unsigned old = xb_add(&bar[XB_XSUB(b.x)], 1u);
        const unsigned gen = old / nloc;
        if (old + 1u == (gen + 1u) * nloc) {
            __builtin_amdgcn_fence(__ATOMIC_RELEASE, "agent");
            asm volatile("s_waitcnt vmcnt(0)" ::: "memory");
            const unsigned og = xb_add(&bar[XB_TOP], 1u);
            const unsigned tg = og / nx;
            if (og + 1u == (tg + 1u) * nx) xb_add(&bar[XB_TOPGEN], 1u);
            else XB_SPIN(xb_ld(&bar[XB_TOPGEN]) == tg, bar);
            __builtin_amdgcn_fence(__ATOMIC_ACQUIRE, "agent");
            xb_add(&bar[XB_XGEN(b.x)], 1u);
            asm volatile("s_waitcnt vmcnt(0)" ::: "memory");
        } else {
            XB_SPIN(xb_ld(&bar[XB_XGEN(b.x)]) == gen, bar);
            __builtin_amdgcn_fence(__ATOMIC_ACQUIRE, "agent");
            asm volatile("s_waitcnt vmcnt(0)" ::: "memory");
        }
    }
    __syncthreads();
}

constexpr int NWAVES = 8, NTHREADS = NWAVES * 64;
constexpr int SEQ = 8192, DM = 1024, M = 2 * SEQ;
constexpr int AB_IN = 1536, DFF = 3584, C_IN = 4128, NEXP = 8;
constexpr float EPS = 1e-6f;
constexpr float QSCALE = 0.125f * 1.4426950408889634f;
constexpr int MOE_MAXROWS = 135 * 256;

constexpr size_t MiB = 1u << 20;
constexpr size_t WS_CTL = 0, CTL_ZERO_BYTES = 256 * 1024;
constexpr size_t WS_SMALL = 1 * MiB;
constexpr size_t SM_GAINS = WS_SMALL, SM_WG = WS_SMALL + 4096, SM_WR = WS_SMALL + 256 * 1024, SM_HIST = WS_SMALL + 512 * 1024, SM_META = WS_SMALL + 640 * 1024;
constexpr size_t WS_TAB = 2 * MiB;
constexpr size_t WS_W_ABIN = 6 * MiB, WS_W_ABOUT = 9 * MiB, WS_W_FGU = 11 * MiB, WS_W_FD = 25 * MiB, WS_W_CIN = 32 * MiB, WS_W_COUT = 40 * MiB;
constexpr size_t WS_XN = 42 * MiB;
constexpr size_t WS_GATES = 74 * MiB;
constexpr size_t WS_GF = 76 * MiB, WS_GB = WS_GF + 512 * 1024, WS_BF = WS_GB + 512 * 1024, WS_BB = WS_BF + 512 * 1024;
constexpr size_t WS_QKV = 80 * MiB, WS_O = 128 * MiB, WS_ACT = 160 * MiB;
constexpr size_t WS_PROJ = 80 * MiB, WS_CQ = 208 * MiB, WS_CK = 240 * MiB, WS_CV = 272 * MiB, WS_OF = 304 * MiB, WS_OB = 336 * MiB, WS_OG = 368 * MiB;
constexpr size_t WS_XG = 2 * MiB, WS_W_MGU = WS_XG + (size_t)MOE_MAXROWS * 2048, WS_MISC2 = 230 * MiB, WS_ACTG = 235 * MiB + 512 * 1024, WS_XN2 = 240 * MiB;
constexpr size_t WS_TOPI = WS_MISC2, WS_TOPG = WS_MISC2 + 256 * 1024, WS_POS = WS_MISC2 + 512 * 1024;
constexpr size_t WS_W_MD = 2 * MiB, WS_Y = 58 * MiB;
constexpr size_t WS_END = WS_ACTG + (size_t)MOE_MAXROWS * DFF * 2;
static_assert(WS_W_MGU + (size_t)NEXP * 7168 * 1024 * 2 <= WS_MISC2 && WS_Y + (size_t)MOE_MAXROWS * 4096 <= WS_MISC2 && WS_W_MD + (size_t)NEXP * 1024 * DFF * 2 <= WS_Y, "moe map");
constexpr int CW_TMO = 0, CW_CODE = 1, CW_BAR = 4096;

constexpr int RING_OFF = 0, RING_BYTES = 131072, LDSCTL_OFF = RING_BYTES, MISC_OFF = LDSCTL_OFF + 320, LDS_BYTES = 147456;

__device__ __forceinline__ float bf2f(unsigned short v) { return __uint_as_float((unsigned)v << 16); }
__device__ __forceinline__ float bflo(unsigned w) { return __uint_as_float(w << 16); }
__device__ __forceinline__ float bfhi(unsigned w) { return __uint_as_float(w & 0xffff0000u); }
__device__ __forceinline__ float wave_sum(float v) {
#pragma unroll
    for (int o = 1; o < 64; o <<= 1) v += __shfl_xor(v, o);
    return v;
}

struct Frame {
    LAS unsigned char* lds; volatile LAS unsigned* MISC; gu32* ctl;
    int tid, lane, wave, vcu, G;
    unsigned char* ws; float* out;
};
struct Args { const float* in[27]; float* out; unsigned char* ws; int ph_lo, ph_hi, use_bar, pad; };

__device__ __forceinline__ int abmap(int n) {
    int tile, wc, p; bool tb = false; int d = n & 63;
    if (n < 512) { const int h = n >> 6; tile = h >> 2; wc = h & 3; }
    else if (n < 640) { tile = 4; wc = (n - 512) >> 6; }
    else if (n < 768) { tile = 5; wc = (n - 640) >> 6; }
    else if (n < 1280) { const int h = (n - 768) >> 6; tile = 2 + (h >> 2); wc = h & 3; tb = true; }
    else if (n < 1408) { tile = 4; wc = 2 + ((n - 1280) >> 6); tb = true; }
    else { tile = 5; wc = 2 + ((n - 1408) >> 6); }
    p = d; if (tb) { if (d >= 16 && d < 32) p = d + 16; else if (d >= 32 && d < 48) p = d - 16; }
    return 256 * tile + 128 * (p >> 5) + 32 * wc + (p & 31);
}
__device__ __forceinline__ int posdim_b(int p) { return (p >= 16 && p < 32) ? p + 16 : (p >= 32 && p < 48) ? p - 16 : p; }
__device__ __forceinline__ int gumap(int j, int up) { return 256 * (j >> 7) + 128 * up + (j & 127); }

template <int MODE>
__device__ __forceinline__ void transpose_item(const float* W, int K, int ldw, int nblk, bf16* WT, const float* gain, int gmask, LAS float* scr, int item, int lane) {
    const int kb = item / nblk, nb = item % nblk, k0 = 64 * kb, n0 = 32 * nb;
#pragma unroll 8
    for (int i = 0; i < 32; ++i) { const int kk = 2 * i + (lane >> 5); float v = W[(size_t)(k0 + kk) * ldw + n0 + (lane & 31)]; if (gain) v *= gain[(k0 + kk) & gmask]; scr[kk * 33 + (lane & 31)] = v; }
    LDS_WAIT(); asm volatile("" ::: "memory");
    const int c = lane & 7;
#pragma unroll
    for (int j = 0; j < 4; ++j) { const int n = (lane >> 3) + 8 * j; const LAS float* s = scr + (8 * c) * 33 + n;
        v4u o; o.x = pk2(s[0 * 33], s[1 * 33]); o.y = pk2(s[2 * 33], s[3 * 33]); o.z = pk2(s[4 * 33], s[5 * 33]); o.w = pk2(s[6 * 33], s[7 * 33]);
        const int nn = n0 + n; const int row = MODE == 0 ? nn : MODE == 1 ? abmap(nn) : MODE == 2 ? gumap(nn, 0) : gumap(nn, 1);
        *(GAS v4u*)(WT + (size_t)row * K + k0 + 8 * c) = o; }
    LDS_WAIT(); asm volatile("" ::: "memory");
}
__device__ __forceinline__ float rms_row_to_bf16(int lane, const float* xrow, bf16* orow) {
    const GAS f32x4* xr = (const GAS f32x4*)xrow + lane;
    f32x4 v[4]; float s = 0.f;
#pragma unroll
    for (int j = 0; j < 4; ++j) { v[j] = xr[64 * j]; s += (v[j].x * v[j].x + v[j].y * v[j].y) + (v[j].z * v[j].z + v[j].w * v[j].w); }
    const float rstd = 1.f / sqrtf(wave_sum(s) * (1.f / DM) + EPS);
    GAS unsigned long long* o8 = (GAS unsigned long long*)orow + lane;
#pragma unroll
    for (int j = 0; j < 4; ++j) o8[64 * j] = (unsigned long long)pk2(v[j].x * rstd, v[j].y * rstd) | ((unsigned long long)pk2(v[j].z * rstd, v[j].w * rstd) << 32);
    return rstd;
}

__device__ __forceinline__ void p0_prologue(Frame& F, const Args& A) {
    LAS float* scr = (LAS float*)(F.lds + RING_OFF + F.wave * 16384);
    const int gw = F.vcu * NWAVES + F.wave, NGW = F.G * NWAVES, lane = F.lane;
    unsigned char* ws = F.ws;
#define in A.in
    constexpr int I_ABIN = 16 * 48, I_ABOUT = 16 * 32, I_G = 16 * 112, I_FD = 56 * 32, I_CIN = 16 * 128, I_COUT = 16 * 32;
    constexpr int NITEMS = I_ABIN + I_ABOUT + 2 * I_G + I_FD + I_CIN + I_COUT;
    for (int it = gw; it < NITEMS; it += NGW) {
        int r = it;
        if (r < I_ABIN) { transpose_item<1>(in[2], 1024, AB_IN, 48, (bf16*)(ws + WS_W_ABIN), in[1], 1023, scr, r, lane); continue; } r -= I_ABIN;
        if (r < I_ABOUT) { transpose_item<0>(in[8], 1024, 1024, 32, (bf16*)(ws + WS_W_ABOUT), nullptr, 0, scr, r, lane); continue; } r -= I_ABOUT;
        if (r < I_G) { transpose_item<2>(in[10], 1024, DFF, 112, (bf16*)(ws + WS_W_FGU), in[9], 1023, scr, r, lane); continue; } r -= I_G;
        if (r < I_G) { transpose_item<3>(in[11], 1024, DFF, 112, (bf16*)(ws + WS_W_FGU), in[9], 1023, scr, r, lane); continue; } r -= I_G;
        if (r < I_FD) { transpose_item<0>(in[12], DFF, 1024, 32, (bf16*)(ws + WS_W_FD), nullptr, 0, scr, r, lane); continue; } r -= I_FD;
        if (r < I_CIN) { transpose_item<0>(in[14], 1024, C_IN, 128, (bf16*)(ws + WS_W_CIN), in[13], 1023, scr, r, lane); continue; } r -= I_CIN;
        transpose_item<0>(in[21], 1024, 1024, 32, (bf16*)(ws + WS_W_COUT), in[20], 127, scr, r, lane);
    }
    const int gt = gw * 64 + lane, NGT = NGW * 64;
    float* tab1 = (float*)(ws + WS_TAB); float* tab2 = tab1 + 2 * 8192 * 32;
    for (int i = gt; i < 8192 * 32; i += NGT) { const int t = i >> 5, f = i & 31;
        { const float inv = exp2f(-13.287712379549449f * (float)(2 * f) * (1.0f / 64.0f)); const float ang = (float)t * inv;
          const double rev = (double)ang * 0.15915494309189535; const float fr = (float)(rev - __builtin_rint(rev)); tab1[i] = __builtin_amdgcn_cosf(fr); tab1[8192 * 32 + i] = __builtin_amdgcn_sinf(fr); }
        { const int ff = f & 15; const float inv = exp2f(-13.287712379549449f * (float)(2 * ff) * (1.0f / 32.0f)); const float pos = (f < 16) ? (float)(t >> 6) : (float)(t & 63); const float ang = pos * inv;
          const double rev = (double)ang * 0.15915494309189535; const float fr = (float)(rev - __builtin_rint(rev)); tab2[i] = __builtin_amdgcn_cosf(fr); tab2[8192 * 32 + i] = __builtin_amdgcn_sinf(fr); }
    }
    float* gains = (float*)(ws + SM_GAINS);
    for (int i = gt; i < 256; i += NGT) { const int sel = i >> 6, p = i & 63; float v;
        if (sel == 0) v = in[3][p]; else if (sel == 1) v = in[4][p]; else if (sel == 2) v = in[6][posdim_b(p)]; else v = in[7][posdim_b(p)];
        gains[i] = v; }
    float* wg = (float*)(ws + SM_WG);
    for (int i = gt; i < 1024 * 32; i += NGT) { const int k = i >> 5, j = i & 31; wg[((k >> 2) * 32 + j) * 4 + (k & 3)] = in[13][k] * in[14][(size_t)k * C_IN + 4096 + j]; }
    float* wrr = (float*)(ws + SM_WR);
    for (int i = gt; i < 1024 * 8; i += NGT) wrr[i] = in[22][i >> 3] * in[23][i];
    for (int m = gw; m < M; m += NGW) rms_row_to_bf16(lane, in[0] + (size_t)m * DM, (bf16*)(ws + WS_XN) + (size_t)m * DM);
#undef in
}

__device__ __forceinline__ void phase_rms(Frame& F, const float* x, bf16* xn) {
    const int gw = F.vcu * NWAVES + F.wave, NGW = F.G * NWAVES;
    for (int m = gw; m < M; m += NGW) rms_row_to_bf16(F.lane, x + (size_t)m * DM, xn + (size_t)m * DM);
}
typedef float f32x16 __attribute__((ext_vector_type(16)));
__device__ __forceinline__ void phase_gates(Frame& F, const float* x, float* gates) {
    const int gw = F.vcu * NWAVES + F.wave, NGW = F.G * NWAVES, lane = F.lane, i = lane & 31, h = lane >> 5;
    const float* wg = (const float*)(F.ws + SM_WG);
    for (int rb = gw; rb < M / 32; rb += NGW) {
        const float* xr = x + (size_t)(rb * 32 + i) * DM + 4 * h; const float* wp = wg + (size_t)(h * 32 + i) * 4;
        f32x16 acc; for (int r = 0; r < 16; ++r) acc[r] = 0.f; float ss = 0.f;
#pragma unroll 4
        for (int c = 0; c < 128; ++c) {
            const f32x4 a = *(const f32x4*)(xr + 8 * c), b = *(const f32x4*)(wp + (size_t)c * 256);
            ss += (a.x * a.x + a.y * a.y) + (a.z * a.z + a.w * a.w);
            acc = __builtin_amdgcn_mfma_f32_32x32x2f32(a.x, b.x, acc, 0, 0, 0); acc = __builtin_amdgcn_mfma_f32_32x32x2f32(a.y, b.y, acc, 0, 0, 0);
            acc = __builtin_amdgcn_mfma_f32_32x32x2f32(a.z, b.z, acc, 0, 0, 0); acc = __builtin_amdgcn_mfma_f32_32x32x2f32(a.w, b.w, acc, 0, 0, 0);
        }
        ss += __shfl_xor(ss, 32);
        const float rstd = 1.f / sqrtf(ss * (1.f / DM) + EPS);
#pragma unroll
        for (int r = 0; r < 16; ++r) { const int row = (r & 3) + 8 * (r >> 2) + 4 * h; const float rs = __shfl(rstd, row); gates[(size_t)(rb * 32 + row) * 32 + i] = acc[r] * rs; }
    }
}

__device__ __forceinline__ void phase_conv(Frame& F, const Args& A) {
    const int gw = F.vcu * NWAVES + F.wave, NGW = F.G * NWAVES, lane = F.lane;
    const bf16* proj = (const bf16*)(F.ws + WS_PROJ); const float* cw = A.in[15];
    for (int it = gw; it < 512 * 6; it += NGW) {
        const int run = it / 6, sh = it % 6, s = sh >> 1, hh = sh & 1;
        const int cb = 1024 * s + 512 * hh + 8 * lane;
        bf16* dst = (bf16*)(F.ws + (s == 0 ? WS_CQ : s == 1 ? WS_CK : WS_CV)) + 512 * hh + 8 * lane;
        float w[5][8];
#pragma unroll
        for (int j = 0; j < 5; ++j) { const f32x4 a = *(const f32x4*)(cw + j * 3072 + cb), b = *(const f32x4*)(cw + j * 3072 + cb + 4); w[j][0] = a.x; w[j][1] = a.y; w[j][2] = a.z; w[j][3] = a.w; w[j][4] = b.x; w[j][5] = b.y; w[j][6] = b.z; w[j][7] = b.w; }
        const int row0 = run * 32, t0 = row0 & (SEQ - 1);
        float win[5][8];
#define ldrow(tt_, dstv) do { const int tt = (tt_); if (tt < 0 || tt >= SEQ) { _Pragma("unroll") for (int e = 0; e < 8; ++e) dstv[e] = 0.f; } \
            else { const v4u r = *(const GAS v4u*)(proj + (size_t)(row0 - t0 + tt) * 4096 + cb); \
                dstv[0] = bflo(r.x); dstv[1] = bfhi(r.x); dstv[2] = bflo(r.y); dstv[3] = bfhi(r.y); dstv[4] = bflo(r.z); dstv[5] = bfhi(r.z); dstv[6] = bflo(r.w); dstv[7] = bfhi(r.w); } } while (0)
        ldrow(t0 - 2, win[0]); ldrow(t0 - 1, win[1]); ldrow(t0, win[2]); ldrow(t0 + 1, win[3]);
        for (int q = 0; q < 32; ++q) {
            ldrow(t0 + q + 2, win[4]);
            float y[8]; float ss = 0.f;
#pragma unroll
            for (int e = 0; e < 8; ++e) { float a = w[0][e] * win[0][e]; a += w[1][e] * win[1][e]; a += w[2][e] * win[2][e]; a += w[3][e] * win[3][e]; a += w[4][e] * win[4][e];
                a = a / (1.0f + __expf(-a)); y[e] = a; ss += a * a; }
            float sc = 1.f;
            if (s < 2) { ss += __shfl_xor(ss, 1); ss += __shfl_xor(ss, 2); ss += __shfl_xor(ss, 4); ss += __shfl_xor(ss, 8); sc = (1.f / sqrtf(ss + EPS)) * (s == 0 ? 0.08838834764831845f : 1.f); }
            v4u o; o.x = pk2(y[0] * sc, y[1] * sc); o.y = pk2(y[2] * sc, y[3] * sc); o.z = pk2(y[4] * sc, y[5] * sc); o.w = pk2(y[6] * sc, y[7] * sc);
            *(GAS v4u*)(dst + (size_t)(row0 + q) * 1024) = o;
#pragma unroll
            for (int j = 0; j < 4; ++j)
#pragma unroll
                for (int e = 0; e < 8; ++e) win[j][e] = win[j + 1][e];
        }
    }
#undef ldrow
    const float* gates = (const float*)(F.ws + WS_GATES);
    float* GFp = (float*)(F.ws + WS_GF); float* GBp = (float*)(F.ws + WS_GB); float* BFp = (float*)(F.ws + WS_BF); float* BBp = (float*)(F.ws + WS_BB);
    const int gt = gw * 64 + lane, NGT = NGW * 64;
    for (int i = gt; i < M * 8; i += NGT) { const int row = i >> 3, hd = i & 7; const float* gr = gates + (size_t)row * 32;
        { const float xx = gr[hd] + A.in[17][hd]; const float sp = xx > 20.f ? xx : log1pf(__expf(xx)); GFp[i] = -__expf(A.in[16][hd]) * sp; BFp[i] = 1.f / (1.f + __expf(-gr[8 + hd])); }
        { const float xx = gr[16 + hd] + A.in[19][hd]; const float sp = xx > 20.f ? xx : log1pf(__expf(xx)); GBp[i] = -__expf(A.in[18][hd]) * sp; BBp[i] = 1.f / (1.f + __expf(-gr[24 + hd])); }
    }
}

__device__ __forceinline__ void phase_onorm(Frame& F) {
    const int gw = F.vcu * NWAVES + F.wave, NGW = F.G * NWAVES, lane = F.lane;
    const bf16* of = (const bf16*)(F.ws + WS_OF); const bf16* ob = (const bf16*)(F.ws + WS_OB); const bf16* proj = (const bf16*)(F.ws + WS_PROJ); bf16* og = (bf16*)(F.ws + WS_OG);
    for (int m = gw; m < M; m += NGW) {
        float o[16], z[16]; float ss = 0.f;
#pragma unroll
        for (int hlf = 0; hlf < 2; ++hlf) { const size_t off = (size_t)m * 1024 + 16 * lane + 8 * hlf;
            const v4u a = *(const GAS v4u*)(of + off), b = *(const GAS v4u*)(ob + off), c = *(const GAS v4u*)(proj + (size_t)m * 4096 + 3072 + 16 * lane + 8 * hlf);
            const unsigned aw[4] = {a.x, a.y, a.z, a.w}, bw[4] = {b.x, b.y, b.z, b.w}, cw[4] = {c.x, c.y, c.z, c.w};
#pragma unroll
            for (int e = 0; e < 4; ++e) { o[8 * hlf + 2 * e] = bflo(aw[e]) + bflo(bw[e]); o[8 * hlf + 2 * e + 1] = bfhi(aw[e]) + bfhi(bw[e]); z[8 * hlf + 2 * e] = bflo(cw[e]); z[8 * hlf + 2 * e + 1] = bfhi(cw[e]); } }
#pragma unroll
        for (int e = 0; e < 16; ++e) ss += o[e] * o[e];
        ss += __shfl_xor(ss, 1); ss += __shfl_xor(ss, 2); ss += __shfl_xor(ss, 4);
        const float r = 1.f / sqrtf(ss * (1.f / 128.f) + EPS);
        unsigned w[8];
#pragma unroll
        for (int e = 0; e < 8; ++e) { const float a = o[2 * e] * r * (z[2 * e] / (1.f + __expf(-z[2 * e]))), b = o[2 * e + 1] * r * (z[2 * e + 1] / (1.f + __expf(-z[2 * e + 1]))); w[e] = pk2(a, b); }
        GAS v4u* dst = (GAS v4u*)(og + (size_t)m * 1024 + 16 * lane); dst[0] = (v4u){w[0], w[1], w[2], w[3]}; dst[1] = (v4u){w[4], w[5], w[6], w[7]};
    }
}

__device__ __forceinline__ void phase_cvt_mgu(Frame& F, const Args& A) {
    LAS float* scr = (LAS float*)(F.lds + RING_OFF + F.wave * 16384);
    const int gw = F.vcu * NWAVES + F.wave, NGW = F.G * NWAVES;
    constexpr int I_G = 16 * 112;
    for (int it = gw; it < NEXP * 2 * I_G; it += NGW) { const int e = it / (2 * I_G), r = it % (2 * I_G); bf16* dst = (bf16*)(F.ws + WS_W_MGU) + (size_t)e * 7168 * 1024;
        if (r < I_G) transpose_item<2>(A.in[24] + (size_t)e * 1024 * DFF, 1024, DFF, 112, dst, A.in[22], 1023, scr, r, F.lane);
        else transpose_item<3>(A.in[25] + (size_t)e * 1024 * DFF, 1024, DFF, 112, dst, A.in[22], 1023, scr, r - I_G, F.lane); }
}
__device__ __forceinline__ void phase_cvt_md(Frame& F, const Args& A) {
    LAS float* scr = (LAS float*)(F.lds + RING_OFF + F.wave * 16384);
    const int gw = F.vcu * NWAVES + F.wave, NGW = F.G * NWAVES;
    constexpr int I_D = 56 * 32;
    for (int it = gw; it < NEXP * I_D; it += NGW) { const int e = it / I_D, r = it % I_D;
        transpose_item<0>(A.in[26] + (size_t)e * DFF * 1024, DFF, 1024, 32, (bf16*)(F.ws + WS_W_MD) + (size_t)e * 1024 * DFF, nullptr, 0, scr, r, F.lane); }
}
__device__ __forceinline__ void phase_route_a(Frame& F) {
    LAS int* hist = (LAS int*)(F.lds + RING_OFF + 120 * 1024);
    const float* wr = (const float*)(F.ws + SM_WR); const float* x3 = F.out; bf16* xn = (bf16*)(F.ws + WS_XN2);
    int* topi = (int*)(F.ws + WS_TOPI); float* topg = (float*)(F.ws + WS_TOPG); int* histg = (int*)(F.ws + SM_HIST);
    const int lane = F.lane;
    for (int tile = F.vcu; tile < M / 64; tile += F.G) {
        if (F.tid < 8) hist[F.tid] = 0;
        __syncthreads();
        for (int q = 0; q < 8; ++q) { const int m = tile * 64 + F.wave * 8 + q;
            const GAS f32x4* xr = (const GAS f32x4*)(x3 + (size_t)m * DM) + lane;
            f32x4 v[4]; float s = 0.f;
#pragma unroll
            for (int j = 0; j < 4; ++j) { v[j] = xr[64 * j]; s += (v[j].x * v[j].x + v[j].y * v[j].y) + (v[j].z * v[j].z + v[j].w * v[j].w); }
            const float rstd = 1.f / sqrtf(wave_sum(s) * (1.f / DM) + EPS);
            GAS unsigned long long* o8 = (GAS unsigned long long*)(xn + (size_t)m * DM) + lane;
            float lg[8];
#pragma unroll
            for (int e = 0; e < 8; ++e) lg[e] = 0.f;
#pragma unroll
            for (int j = 0; j < 4; ++j) { o8[64 * j] = (unsigned long long)pk2(v[j].x * rstd, v[j].y * rstd) | ((unsigned long long)pk2(v[j].z * rstd, v[j].w * rstd) << 32);
                const float xv[4] = {v[j].x, v[j].y, v[j].z, v[j].w};
#pragma unroll
                for (int c = 0; c < 4; ++c) { const int k = 4 * (lane + 64 * j) + c; const f32x4 w0 = *(const f32x4*)(wr + k * 8), w1 = *(const f32x4*)(wr + k * 8 + 4);
                    lg[0] += xv[c] * w0.x; lg[1] += xv[c] * w0.y; lg[2] += xv[c] * w0.z; lg[3] += xv[c] * w0.w; lg[4] += xv[c] * w1.x; lg[5] += xv[c] * w1.y; lg[6] += xv[c] * w1.z; lg[7] += xv[c] * w1.w; } }
#pragma unroll
            for (int e = 0; e < 8; ++e) lg[e] = wave_sum(lg[e]) * rstd;
            int e0 = 0; float v0 = lg[0];
#pragma unroll
            for (int e = 1; e < 8; ++e) if (lg[e] > v0) { v0 = lg[e]; e0 = e; }
            int e1 = -1; float v1 = -INFINITY;
#pragma unroll
            for (int e = 0; e < 8; ++e) if (e != e0 && lg[e] > v1) { v1 = lg[e]; e1 = e; }
            const float ex = __expf(v1 - v0), g0 = 1.f / (1.f + ex), g1 = ex * g0;
            if (lane == 0) { topi[2 * m] = e0; topi[2 * m + 1] = e1; topg[2 * m] = g0; topg[2 * m + 1] = g1; __hip_atomic_fetch_add(&hist[e0], 1, __ATOMIC_RELAXED, __HIP_MEMORY_SCOPE_WORKGROUP); __hip_atomic_fetch_add(&hist[e1], 1, __ATOMIC_RELAXED, __HIP_MEMORY_SCOPE_WORKGROUP); }
        }
        __syncthreads();
        if (F.tid < 8) histg[tile * 8 + F.tid] = hist[F.tid];
        __syncthreads();
    }
}
__device__ __forceinline__ void phase_route_b(Frame& F) {
    LAS int* cnt = (LAS int*)(F.lds + RING_OFF);
    LAS int* offs = cnt + 2048;
    LAS int* tpos = cnt + 2048 + 64;
    const int* histg = (const int*)(F.ws + SM_HIST); const int* topi = (const int*)(F.ws + WS_TOPI); int* pos = (int*)(F.ws + WS_POS); int* meta = (int*)(F.ws + SM_META);
    const bf16* xn = (const bf16*)(F.ws + WS_XN2); bf16* xg = (bf16*)(F.ws + WS_XG);
    for (int i = F.tid; i < 2048; i += NTHREADS) cnt[i] = histg[i];
    __syncthreads();
    if (F.tid < 8) { int run = 0; for (int t = 0; t < 256; ++t) { const int c = cnt[t * 8 + F.tid]; cnt[t * 8 + F.tid] = run; run += c; } offs[16 + F.tid] = run; }
    __syncthreads();
    if (F.tid == 0) { int o = 0; for (int e = 0; e < 8; ++e) { offs[e] = o; o += (offs[16 + e] + 255) & ~255; } offs[8] = o; }
    __syncthreads();
    if (blockIdx.x == 0 && F.tid < 9) meta[F.tid] = offs[F.tid];
    for (int tile = F.vcu; tile < M / 64; tile += F.G) {
        if (F.wave == 0) { const int m = tile * 64 + F.lane; const int e0 = topi[2 * m], e1 = topi[2 * m + 1]; int p0 = 0, p1 = 0;
#pragma unroll
            for (int e = 0; e < 8; ++e) { const unsigned long long mk = __ballot(e0 == e || e1 == e); const int rank = __popcll(mk & ((1ull << F.lane) - 1ull)); const int base = offs[e] + cnt[tile * 8 + e];
                if (e0 == e) p0 = base + rank; if (e1 == e) p1 = base + rank; }
            pos[2 * m] = p0; pos[2 * m + 1] = p1; tpos[2 * F.lane] = p0; tpos[2 * F.lane + 1] = p1; }
        __syncthreads();
        for (int c = F.wave; c < 128; c += NWAVES) { const int tk = c >> 1, m = tile * 64 + tk; const int p = tpos[c];
            const GAS v4u* src = (const GAS v4u*)(xn + (size_t)m * DM) + F.lane; GAS v4u* dst = (GAS v4u*)(xg + (size_t)p * DM) + F.lane; dst[0] = src[0]; dst[64] = src[64]; }
        __syncthreads();
    }
    if (blockIdx.x < 8) { const int e = blockIdx.x; const int r0 = offs[e] + offs[16 + e], r1 = offs[e + 1];
        for (int r = r0 + F.wave; r < r1; r += NWAVES) { GAS v4u* dst = (GAS v4u*)(xg + (size_t)r * DM) + F.lane; dst[0] = (v4u){0u, 0u, 0u, 0u}; dst[64] = (v4u){0u, 0u, 0u, 0u}; } }
}
__device__ __forceinline__ void phase_combine(Frame& F) {
    const int gw = F.vcu * NWAVES + F.wave, NGW = F.G * NWAVES, lane = F.lane;
    const float* Y = (const float*)(F.ws + WS_Y); const int* pos = (const int*)(F.ws + WS_POS); const float* topg = (const float*)(F.ws + WS_TOPG);
    for (int m = gw; m < M; m += NGW) { const int p0 = pos[2 * m], p1 = pos[2 * m + 1]; const float g0 = topg[2 * m], g1 = topg[2 * m + 1];
        GAS f32x4* o = (GAS f32x4*)(F.out + (size_t)m * DM) + lane; const GAS f32x4* y0 = (const GAS f32x4*)(Y + (size_t)p0 * DM) + lane; const GAS f32x4* y1 = (const GAS f32x4*)(Y + (size_t)p1 * DM) + lane;
#pragma unroll
        for (int j = 0; j < 4; ++j) o[64 * j] = o[64 * j] + g0 * y0[64 * j] + g1 * y1[64 * j]; }
}

__global__ void __launch_bounds__(256) naive_attn(const bf16* __restrict__ QKV, const float* __restrict__ sink, bf16* __restrict__ O) {
    __shared__ float Ks[64][64]; __shared__ float Vs[64][64];
    const int b = blockIdx.z, h = blockIdx.y, qb = blockIdx.x, tid = threadIdx.x;
    const int tq = qb * 256 + tid; const size_t row = (size_t)b * SEQ + tq;
    const bool win = h < 8; const int qcol = win ? 64 * h : 512 + 64 * (h - 8); const int kvh = win ? (h >> 2) : 2 + ((h - 8) >> 2); const int kcol = 1024 + 64 * kvh, vcol = 1280 + 64 * kvh;
    float q[64], o[64];
#pragma unroll
    for (int d = 0; d < 64; ++d) { q[d] = bf2f(QKV[row * 1536 + qcol + d]); o[d] = 0.f; }
    float mx = -INFINITY, l = 0.f;
    const int t_lo = win ? (qb * 256 - 128 < 0 ? 0 : qb * 256 - 128) : 0, t_hi = win ? (qb * 256 + 384 > SEQ ? SEQ : qb * 256 + 384) : SEQ;
    for (int kt = t_lo; kt < t_hi; kt += 64) {
        __syncthreads();
        for (int i = tid; i < 64 * 64; i += 256) { const int r = i >> 6, d = i & 63; const size_t kr = ((size_t)b * SEQ + kt + r) * 1536; Ks[r][d] = bf2f(QKV[kr + kcol + d]); Vs[r][d] = bf2f(QKV[kr + vcol + d]); }
        __syncthreads();
        for (int j0 = 0; j0 < 64; j0 += 16) {
            float s[16]; float cm = -INFINITY;
#pragma unroll
            for (int jj = 0; jj < 16; ++jj) { float a = 0.f;
#pragma unroll
                for (int d = 0; d < 64; ++d) a += q[d] * Ks[j0 + jj][d];
                const int tk = kt + j0 + jj; const int rel = tq - tk; if (win && (rel > 128 || rel < -128)) a = -INFINITY; s[jj] = a; cm = fmaxf(cm, a); }
            const float mn = fmaxf(mx, cm);
            if (mn == -INFINITY) continue;
            const float f = exp2f(mx - mn); l *= f;
#pragma unroll
            for (int d = 0; d < 64; ++d) o[d] *= f;
#pragma unroll
            for (int jj = 0; jj < 16; ++jj) { const float p = exp2f(s[jj] - mn); l += p;
#pragma unroll
                for (int d = 0; d < 64; ++d) o[d] += p * Vs[j0 + jj][d]; }
            mx = mn;
        }
    }
    if (win) l += exp2f(sink[h] * 1.4426950408889634f - mx);
    const float rl = 1.f / l;
#pragma unroll
    for (int d = 0; d < 64; ++d) O[row * 1024 + 64 * h + d] = (bf16)f2bf(o[d] * rl);
}
__global__ void __launch_bounds__(256) naive_gdn(const bf16* __restrict__ CQ, const bf16* __restrict__ CK, const bf16* __restrict__ CV, const float* __restrict__ G, const float* __restrict__ BETA, bf16* __restrict__ OUT, int dir) {
    __shared__ float ks[2][128], qs[2][128], part[2][2][128], part2[2][2][128];
    const int b = blockIdx.x >> 3, h = blockIdx.x & 7, tid = threadIdx.x, dv = tid & 127, half = tid >> 7;
    float S[64];
#pragma unroll
    for (int i = 0; i < 64; ++i) S[i] = 0.f;
    for (int step = 0; step < SEQ; ++step) {
        const int t = dir ? SEQ - 1 - step : step; const size_t row = (size_t)b * SEQ + t; const int pb = step & 1;
        if (tid < 128) ks[pb][tid] = bf2f(CK[row * 1024 + h * 128 + tid]); else qs[pb][tid - 128] = bf2f(CQ[row * 1024 + h * 128 + tid - 128]);
        const float v = bf2f(CV[row * 1024 + h * 128 + dv]); const float eg = __expf(G[row * 8 + h]), beta = BETA[row * 8 + h];
        __syncthreads();
        float ps = 0.f;
#pragma unroll
        for (int i = 0; i < 64; ++i) { S[i] *= eg; ps += ks[pb][64 * half + i] * S[i]; }
        part[pb][half][dv] = ps;
        __syncthreads();
        const float delta = beta * (v - (part[pb][0][dv] + part[pb][1][dv]));
        float po = 0.f;
#pragma unroll
        for (int i = 0; i < 64; ++i) { S[i] += ks[pb][64 * half + i] * delta; po += qs[pb][64 * half + i] * S[i]; }
        part2[pb][half][dv] = po;
        __syncthreads();
        if (half == 0) OUT[row * 1024 + h * 128 + dv] = (bf16)f2bf(part2[pb][0][dv] + part2[pb][1][dv]);
    }
}

constexpr int NPHASE = 19;
__global__ void __launch_bounds__(NTHREADS, 2) mega(Args args) {
    extern __shared__ __attribute__((aligned(16))) unsigned char lds[];
    Frame F;
    F.lds = (LAS unsigned char*)lds; F.MISC = (volatile LAS unsigned*)(F.lds + MISC_OFF);
    F.tid = threadIdx.x; F.lane = F.tid & 63; F.wave = __builtin_amdgcn_readfirstlane(F.tid >> 6);
    F.G = gridDim.x; { const int bx = blockIdx.x; F.vcu = (F.G % 8 == 0) ? (bx % 8) * (F.G / 8) + bx / 8 : bx; }
    F.ws = args.ws; F.out = args.out; F.ctl = (gu32*)(args.ws + WS_CTL);
    unsigned char* ws = args.ws;
    for (int u = F.tid; u < (LDS_BYTES - LDSCTL_OFF) / 4; u += NTHREADS) ((LAS unsigned*)(F.lds + LDSCTL_OFF))[u] = 0u;
    __syncthreads();
    XcdBarrier bar; bar.bar = (unsigned*)(F.ctl + CW_BAR); bar.x = 0; bar.st = nullptr;
    if (args.use_bar) bar = xcd_barrier_post((unsigned*)(F.ctl + CW_BAR), F.MISC + 8);
    const int lo = args.ph_lo, hi = args.ph_hi;
#define IN(k) (lo <= (k) && (k) < hi)
#define SEAM(k) do { if (IN(k) && IN((k) + 1)) xcd_barrier(bar); } while (0)
    if (IN(0)) { p0_prologue(F, args); } SEAM(0);
    if (IN(1)) { pg8::Gemm g{(const bf16*)(ws + WS_XN), (const bf16*)(ws + WS_W_ABIN), M, AB_IN, DM, 0}; pg8::StaticOrder S; S.init(M, AB_IN, F.G, (int)blockIdx.x);
        const float* tab1 = (const float*)(ws + WS_TAB);
        pg8::EpiQKV E{(bf16*)(ws + WS_QKV), (const float*)(ws + SM_GAINS), tab1, QSCALE, EPS};
        pg8::gemm_phase<pg8::EpiQKV, pg8::StaticOrder, PG8_ALIGN, PG8_SP2>(F.lds + RING_OFF, g, S, E); } SEAM(1);
    SEAM(2);
    if (IN(3)) { pg8::Gemm g{(const bf16*)(ws + WS_O), (const bf16*)(ws + WS_W_ABOUT), M, DM, DM, 0}; pg8::StaticOrder S; S.init(M, DM, F.G, (int)blockIdx.x);
        pg8::EpiResF32 E{args.in[0], args.out, DM};
        pg8::gemm_phase<pg8::EpiResF32, pg8::StaticOrder, PG8_ALIGN, PG8_SP2>(F.lds + RING_OFF, g, S, E); } SEAM(3);
    if (IN(4)) { phase_rms(F, args.out, (bf16*)(ws + WS_XN)); } SEAM(4);
    if (IN(5)) { pg8::Gemm g{(const bf16*)(ws + WS_XN), (const bf16*)(ws + WS_W_FGU), M, 2 * DFF, DM, 0}; pg8::StaticOrder S; S.init(M, 2 * DFF, F.G, (int)blockIdx.x);
        pg8::EpiSwiGLU E{(bf16*)(ws + WS_ACT), DFF};
        pg8::gemm_phase<pg8::EpiSwiGLU, pg8::StaticOrder, PG8_ALIGN, PG8_SP2>(F.lds + RING_OFF, g, S, E); } SEAM(5);
    if (IN(6)) { pg8::Gemm g{(const bf16*)(ws + WS_ACT), (const bf16*)(ws + WS_W_FD), M, DM, DFF, 0}; pg8::StaticOrder S; S.init(M, DM, F.G, (int)blockIdx.x);
        pg8::EpiResF32 E{args.out, args.out, DM};
        pg8::gemm_phase<pg8::EpiResF32, pg8::StaticOrder, PG8_ALIGN, PG8_SP2>(F.lds + RING_OFF, g, S, E); } SEAM(6);
    if (IN(7)) { phase_rms(F, args.out, (bf16*)(ws + WS_XN)); phase_gates(F, args.out, (float*)(ws + WS_GATES)); } SEAM(7);
    if (IN(8)) { pg8::Gemm g{(const bf16*)(ws + WS_XN), (const bf16*)(ws + WS_W_CIN), M, 4096, DM, 0}; pg8::StaticOrder S; S.init(M, 4096, F.G, (int)blockIdx.x);
        pg8::EpiBf16<0> E{(bf16*)(ws + WS_PROJ), 4096, nullptr, 0, 0, 1.f};
        pg8::gemm_phase<pg8::EpiBf16<0>, pg8::StaticOrder, PG8_ALIGN, PG8_SP2>(F.lds + RING_OFF, g, S, E); } SEAM(8);
    if (IN(9)) { phase_conv(F, args); } SEAM(9);
    SEAM(10); SEAM(11);
    if (IN(12)) { phase_onorm(F); } SEAM(12);
    if (IN(13)) { pg8::Gemm g{(const bf16*)(ws + WS_OG), (const bf16*)(ws + WS_W_COUT), M, DM, DM, 0}; pg8::StaticOrder S; S.init(M, DM, F.G, (int)blockIdx.x);
        pg8::EpiResF32 E{args.out, args.out, DM};
        pg8::gemm_phase<pg8::EpiResF32, pg8::StaticOrder, PG8_ALIGN, PG8_SP2>(F.lds + RING_OFF, g, S, E); } SEAM(13);
    if (IN(14)) { phase_route_a(F); phase_cvt_mgu(F, args); } SEAM(14);
    if (IN(15)) { phase_route_b(F); } SEAM(15);
    if (IN(16)) { pg8::Gemm g{(const bf16*)(ws + WS_XG), (const bf16*)(ws + WS_W_MGU), MOE_MAXROWS, 2 * DFF, DM, (size_t)7168 * 1024 * 2}; pg8::MoeOrder S; S.init((const int*)(ws + SM_META), 2 * DFF, F.G, (int)blockIdx.x);
        pg8::EpiSwiGLU E{(bf16*)(ws + WS_ACTG), DFF};
        pg8::gemm_phase<pg8::EpiSwiGLU, pg8::MoeOrder, PG8_ALIGN, PG8_SP2>(F.lds + RING_OFF, g, S, E); } SEAM(16);
    if (IN(17)) { phase_cvt_md(F, args); } SEAM(17);
    if (IN(18)) { pg8::Gemm g{(const bf16*)(ws + WS_ACTG), (const bf16*)(ws + WS_W_MD), MOE_MAXROWS, DM, DFF, (size_t)1024 * DFF * 2}; pg8::MoeOrder S; S.init((const int*)(ws + SM_META), DM, F.G, (int)blockIdx.x);
        pg8::EpiF32 E{(float*)(ws + WS_Y), DM};
        pg8::gemm_phase<pg8::EpiF32, pg8::MoeOrder, PG8_ALIGN, PG8_SP2>(F.lds + RING_OFF, g, S, E); } SEAM(18);
    if (IN(19)) { phase_combine(F); }
#undef IN
#undef SEAM
}

extern "C" void kernel_launch(void* const* d_in, const int* in_sizes, int n_in, void* d_out, int out_size, void* d_ws, size_t ws_size, hipStream_t stream) {
    static int grid = 0;
    if (grid == 0) {
        if (n_in != 27 || in_sizes[0] != M * DM || out_size != M * DM || ws_size < WS_END) { fprintf(stderr, "kernel_launch: unexpected problem (n_in %d, in0 %d, out %d, ws %zu < %zu); nothing launched\n", n_in, n_in > 0 ? in_sizes[0] : -1, out_size, ws_size, (size_t)WS_END); grid = -1; return; }
        int dev = 0, cus = 0, per_cu = 0;
        if (hipGetDevice(&dev) != hipSuccess || hipDeviceGetAttribute(&cus, hipDeviceAttributeMultiprocessorCount, dev) != hipSuccess) { grid = -1; return; }
        if (hipFuncSetAttribute((const void*)mega, hipFuncAttributeMaxDynamicSharedMemorySize, LDS_BYTES) != hipSuccess) { fprintf(stderr, "kernel_launch: hipFuncSetAttribute failed\n"); grid = -1; return; }
        if (hipOccupancyMaxActiveBlocksPerMultiprocessor(&per_cu, (const void*)mega, NTHREADS, LDS_BYTES) != hipSuccess || per_cu < 1) fprintf(stderr, "kernel_launch: occupancy query says %d\n", per_cu);
        (void)hipGetLastError();
        grid = cus;
    }
    if (grid < 0) return;
    (void)hipMemsetAsync((char*)d_ws + WS_CTL, 0, CTL_ZERO_BYTES, stream);
    Args a{};
    for (int i = 0; i < 27; ++i) a.in[i] = (const float*)d_in[i];
    a.out = (float*)d_out; a.ws = (unsigned char*)d_ws; a.use_bar = 0; a.pad = 0;
    unsigned char* ws = (unsigned char*)d_ws;
    auto run = [&](int lo, int hi) { a.ph_lo = lo; a.ph_hi = hi; hipLaunchKernelGGL(mega, dim3(grid), dim3(NTHREADS), LDS_BYTES, stream, a); };
    run(0, 1); run(1, 2);
    hipLaunchKernelGGL(naive_attn, dim3(32, 16, 2), dim3(256), 0, stream, (const bf16*)(ws + WS_QKV), (const float*)d_in[5], (bf16*)(ws + WS_O));
    for (int p = 3; p <= 9; ++p) run(p, p + 1);
    hipLaunchKernelGGL(naive_gdn, dim3(16), dim3(256), 0, stream, (const bf16*)(ws + WS_CQ), (const bf16*)(ws + WS_CK), (const bf16*)(ws + WS_CV), (const float*)(ws + WS_GF), (const float*)(ws + WS_BF), (bf16*)(ws + WS_OF), 0);
    hipLaunchKernelGGL(naive_gdn, dim3(16), dim3(256), 0, stream, (const bf16*)(ws + WS_CQ), (const bf16*)(ws + WS_CK), (const bf16*)(ws + WS_CV), (const float*)(ws + WS_GB), (const float*)(ws + WS_BB), (bf16*)(ws + WS_OB), 1);
    for (int p = 12; p <= 19; ++p) run(p, p + 1);
}
```

```cpp
#include <hip/hip_runtime.h>
#include <cstdio>
#include <cstdint>
#include <cmath>
namespace pg8 {
#define PG8_LAS __attribute__((address_space(3)))
typedef unsigned short bf16_t;
typedef short bf16x8 __attribute__((ext_vector_type(8)));
typedef float f32x4 __attribute__((ext_vector_type(4)));
typedef unsigned u32x4 __attribute__((ext_vector_type(4)));
constexpr int BM = 256, BK = 64, HALF = 128, HTB = HALF * BK * 2  , STAGE_BYTES = 8 * HTB, NXCD = 8, WGM = 8;

__host__ __device__ __forceinline__ int lds_byte(int r, int c) { const int st = (r >> 4) * 2 + (c >> 5), rr = r & 15, cc = c & 31, ob = rr * 64 + cc * 2; return st * 1024 + (ob ^ (((ob >> 9) & 1) << 5)); }
__host__ __device__ __forceinline__ void stage_rc(int b, int& R, int& C) { const int st = b / 1024, sb = b % 1024, swz = sb ^ (((sb >> 9) & 1) << 5); R = (st >> 1) * 16 + swz / 64; C = (st & 1) * 32 + (swz % 64) / 2; }
__host__ __device__ __forceinline__ int perm32(int rho) { const int n = rho >> 4, i = rho & 15; return 8 * (i >> 2) + 4 * n + (i & 3); }

struct Unit { int pm, pn, e, k0, nt, part, tix; };
struct Gemm { const bf16_t* A; const bf16_t* Bt; int M, N, K; size_t estride; int esplit = 1 << 30; long long edelta = 0; };

struct StaticOrder {
    int nM, nN, nwg, G, c, ntk;
    __host__ __device__ __forceinline__ void init(int M, int N, int G_, int c_, int K_) { nM = M / BM; nN = N / BM; nwg = nM * nN; G = G_; c = c_; ntk = K_ / BK; }
    __host__ __device__ __forceinline__ bool next(int i, Unit& u) const {
        const long L = (long)i * G + c; if (L >= nwg) return false;
        int wgid = (int)L; { const int q = nwg / NXCD, r = nwg % NXCD, xcd = wgid % NXCD, off = wgid / NXCD; wgid = (xcd < r ? xcd * (q + 1) : r * (q + 1) + (xcd - r) * q) + off; }
        const int nig = WGM * nN, gid = wgid / nig, fm = gid * WGM, gsz = (nM - fm) < WGM ? (nM - fm) : WGM;
        u.pm = fm + ((wgid % nig) % gsz); u.pn = (wgid % nig) / gsz; u.e = 0; u.k0 = 0; u.nt = ntk; u.part = -1; u.tix = 0; return true;
    }
    __device__ __forceinline__ void a_ready(const Unit&) const {}
    __device__ __forceinline__ void done(const Unit&) const {}
};

typedef float f32x2c __attribute__((ext_vector_type(2))); typedef __bf16 bf16x2c __attribute__((ext_vector_type(2)));
__device__ __forceinline__ unsigned cvt_pk_bf16(float lo, float hi) { const f32x2c v = {lo, hi}; const bf16x2c b = __builtin_convertvector(v, bf16x2c); return __builtin_bit_cast(unsigned, b); }
typedef float f32x2 __attribute__((ext_vector_type(2)));
__device__ __forceinline__ f32x2 gelu_pk(f32x2 v) {
    const f32x2 av = __builtin_elementwise_abs(v), d = av * 0.2316418882f + 1.0f;
    f32x2 t; t.x = __builtin_amdgcn_rcpf(d.x); t.y = __builtin_amdgcn_rcpf(d.y);
    f32x2 q = t * 0.5307027145f + (-0.7265760135f); q = q * t + 0.7107068705f; q = q * t + (-0.142248368f); q = q * t + 0.127414796f; q = q * t;
    const f32x2 s = (v * v) * (-0.72134752044f);
    f32x2 e; e.x = __builtin_amdgcn_exp2f(s.x); e.y = __builtin_amdgcn_exp2f(s.y);
    const f32x2 m = v * (q * e), r = v - m;
    f32x2 o; o.x = v.x < 0.f ? m.x : r.x; o.y = v.y < 0.f ? m.y : r.y; return o;
}

template <int ACT  > struct EpiBf16 {
    static constexpr bool PERM = true, AFTER_DRAIN = false; static_assert(ACT == 0 || ACT == 1, "EpiBf16: ACT is 0 (none) or 1 (gelu_pk)");
    bf16_t* O; int ldc; const float* bias; int split_cols; size_t split_stride; float scale0;
    __device__ __forceinline__ void operator()(const f32x4 (&acc)[2][2][4][2], const Unit& u, int wr, int wc, int fr, int fq) const {
        const int row0 = u.pm * BM + wr * 64 + fr; int colt = u.pn * BM; bf16_t* base = O;
        float sc = 1.f; if (split_cols) { const int t = colt / split_cols; base += (size_t)t * split_stride; colt -= t * split_cols; if (t == 0) sc = scale0; }
        const int col0 = colt + wc * 32 + 8 * fq, bcol0 = u.pn * BM + wc * 32 + 8 * fq;
        f32x4 bv[2][2];
#pragma unroll
        for (int bj = 0; bj < 2; ++bj)
#pragma unroll
            for (int n = 0; n < 2; ++n) bv[bj][n] = bias ? *(const f32x4*)(bias + bcol0 + bj * HALF + 4 * n) : (f32x4){0.f, 0.f, 0.f, 0.f};
#pragma unroll
        for (int ai = 0; ai < 2; ++ai)
#pragma unroll
            for (int m = 0; m < 4; ++m) { bf16_t* rowp = base + (size_t)(row0 + ai * HALF + m * 16) * ldc + col0;
#pragma unroll
                for (int bj = 0; bj < 2; ++bj) { f32x4 v0 = acc[ai][bj][m][0] + bv[bj][0], v1 = acc[ai][bj][m][1] + bv[bj][1];
                    if (ACT == 1) { f32x2 a = gelu_pk((f32x2){v0[0], v0[1]}), b = gelu_pk((f32x2){v0[2], v0[3]}), c = gelu_pk((f32x2){v1[0], v1[1]}), d = gelu_pk((f32x2){v1[2], v1[3]});
                        v0 = (f32x4){a.x, a.y, b.x, b.y}; v1 = (f32x4){c.x, c.y, d.x, d.y}; }
                    v0 = v0 * sc; v1 = v1 * sc; u32x4 w; w.x = cvt_pk_bf16(v0[0], v0[1]); w.y = cvt_pk_bf16(v0[2], v0[3]); w.z = cvt_pk_bf16(v1[0], v1[1]); w.w = cvt_pk_bf16(v1[2], v1[3]);
                    *(u32x4*)(rowp + bj * HALF) = w; } }
    }
};

__device__ __forceinline__ float swiglu_f(float g, float u) { return (g * u) * __builtin_amdgcn_rcpf(1.0f + __builtin_amdgcn_exp2f(g)); }
__device__ __forceinline__ float silu_f(float x) { return x * __builtin_amdgcn_rcpf(1.0f + __builtin_amdgcn_exp2f(-1.4426950408889634f * x)); }
__device__ __forceinline__ float row_rstd(const float* ssp, int row, float eps) {
    const f32x4* p = (const f32x4*)(ssp + (size_t)row * 16); const f32x4 a = p[0], b = p[1], c = p[2], d = p[3];
    const float s = ((a[0] + a[1]) + (a[2] + a[3])) + ((b[0] + b[1]) + (b[2] + b[3])) + (((c[0] + c[1]) + (c[2] + c[3])) + ((d[0] + d[1]) + (d[2] + d[3])));
    return 1.0f / sqrtf(s * (1.0f / 1024.0f) + eps); }
struct EpiResF32 {
    static constexpr bool PERM = false, AFTER_DRAIN = false;
    const float* base; float* out; int ldc; bf16_t* xb; float* ssp;
    __device__ __forceinline__ void operator()(const f32x4 (&acc)[2][2][4][2], const Unit& u, int wr, int wc, int fr, int fq) const {
        typedef unsigned u32x2e __attribute__((ext_vector_type(2)));
        const int col0 = u.pn * BM + wc * 32 + 4 * fq;
#pragma unroll
        for (int ai = 0; ai < 2; ++ai)
#pragma unroll
            for (int m = 0; m < 4; ++m) { const int row = u.pm * BM + ai * HALF + wr * 64 + m * 16 + fr; const size_t off = (size_t)row * ldc + col0; float ss = 0.f;
#pragma unroll
                for (int bj = 0; bj < 2; ++bj)
#pragma unroll
                    for (int n = 0; n < 2; ++n) { const f32x4 bs = *(const f32x4*)(base + off + bj * HALF + n * 16); const f32x4 o = bs + acc[ai][bj][m][n]; *(f32x4*)(out + off + bj * HALF + n * 16) = o;
                        if (xb) { u32x2e w; w.x = cvt_pk_bf16(o[0], o[1]); w.y = cvt_pk_bf16(o[2], o[3]); *(u32x2e*)(xb + off + bj * HALF + n * 16) = w; ss += (o[0] * o[0] + o[1] * o[1]) + (o[2] * o[2] + o[3] * o[3]); } }
                if (xb) { ss += __shfl_xor(ss, 16); ss += __shfl_xor(ss, 32); if (fq == 0) ssp[(size_t)row * 16 + u.pn * 4 + wc] = ss; }
                if (m & 1) asm volatile("" ::: "memory"); }
    }
};
template <bool F32BASE> struct EpiResBf16T {
    static constexpr bool PERM = true, AFTER_DRAIN = false;
    const float* basef; int ldb; const bf16_t* baseb; bf16_t* out; int ldo;
    __device__ __forceinline__ void operator()(const f32x4 (&acc)[2][2][4][2], const Unit& u, int wr, int wc, int fr, int fq) const {
        typedef __attribute__((address_space(1))) const u32x4 gu4c; typedef __attribute__((address_space(1))) const f32x4 gf4c;
        const int col0 = u.pn * BM + wc * 32 + 8 * fq, row0 = u.pm * BM + wr * 64 + fr;
        if constexpr (!F32BASE) {
            u32x4 rw[2][4][2];
#pragma unroll
            for (int ai = 0; ai < 2; ++ai)
#pragma unroll
                for (int m = 0; m < 4; ++m)
#pragma unroll
                    for (int bj = 0; bj < 2; ++bj) rw[ai][m][bj] = *(gu4c*)(baseb + (size_t)(row0 + ai * HALF + m * 16) * ldo + col0 + bj * HALF);
#pragma unroll
            for (int ai = 0; ai < 2; ++ai)
#pragma unroll
                for (int m = 0; m < 4; ++m)
#pragma unroll
                    for (int bj = 0; bj < 2; ++bj) { const u32x4 w0 = rw[ai][m][bj];
                        const f32x4 b0 = (f32x4){__uint_as_float(w0.x << 16), __uint_as_float(w0.x & 0xffff0000u), __uint_as_float(w0.y << 16), __uint_as_float(w0.y & 0xffff0000u)};
                        const f32x4 b1 = (f32x4){__uint_as_float(w0.z << 16), __uint_as_float(w0.z & 0xffff0000u), __uint_as_float(w0.w << 16), __uint_as_float(w0.w & 0xffff0000u)};
                        const f32x4 o0 = b0 + acc[ai][bj][m][0], o1 = b1 + acc[ai][bj][m][1];
                        u32x4 w; w.x = cvt_pk_bf16(o0[0], o0[1]); w.y = cvt_pk_bf16(o0[2], o0[3]); w.z = cvt_pk_bf16(o1[0], o1[1]); w.w = cvt_pk_bf16(o1[2], o1[3]);
                        *(u32x4*)(out + (size_t)(row0 + ai * HALF + m * 16) * ldo + col0 + bj * HALF) = w; }
        } else {
#pragma unroll
            for (int ai = 0; ai < 2; ++ai) { f32x4 rb[4][2][2];
#pragma unroll
                for (int m = 0; m < 4; ++m)
#pragma unroll
                    for (int bj = 0; bj < 2; ++bj) { const float* bp = basef + (size_t)(row0 + ai * HALF + m * 16) * ldb + col0 + bj * HALF; rb[m][bj][0] = *(gf4c*)bp; rb[m][bj][1] = *(gf4c*)(bp + 4); }
#pragma unroll
                for (int m = 0; m < 4; ++m)
#pragma unroll
                    for (int bj = 0; bj < 2; ++bj) { const f32x4 o0 = rb[m][bj][0] + acc[ai][bj][m][0], o1 = rb[m][bj][1] + acc[ai][bj][m][1];
                        u32x4 w; w.x = cvt_pk_bf16(o0[0], o0[1]); w.y = cvt_pk_bf16(o0[2], o0[3]); w.z = cvt_pk_bf16(o1[0], o1[1]); w.w = cvt_pk_bf16(o1[2], o1[3]);
                        *(u32x4*)(out + (size_t)(row0 + ai * HALF + m * 16) * ldo + col0 + bj * HALF) = w; }
                asm volatile("" ::: "memory"); }
        }
    }
};
struct EpiF32 {
    static constexpr bool PERM = true, AFTER_DRAIN = false;
    bf16_t* out; int ldc; float* part; int T;
    __device__ __forceinline__ void operator()(const f32x4 (&acc)[2][2][4][2], const Unit& u, int wr, int wc, int fr, int fq) const {
        const bool pt = u.part >= 0;
        char* base = pt ? (char*)(part + (size_t)(u.part * T + u.tix) * 65536 + wc * 32 + 8 * fq) : (char*)(out + (size_t)(u.pm * BM) * ldc + u.pn * BM + wc * 32 + 8 * fq);
        const size_t pitch = pt ? 1024 : (size_t)ldc * 2; int r0 = wr * 64 + fr; asm volatile("" : "+v"(r0));
#pragma unroll
        for (int ai = 0; ai < 2; ++ai)
#pragma unroll
            for (int m = 0; m < 4; ++m) { char* rowp = base + (size_t)(ai * HALF + m * 16 + r0) * pitch;
#pragma unroll
                for (int bj = 0; bj < 2; ++bj) { const f32x4 v0 = acc[ai][bj][m][0], v1 = acc[ai][bj][m][1];
                    if (pt) { *(f32x4*)(rowp + bj * HALF * 4) = v0; *(f32x4*)(rowp + bj * HALF * 4 + 16) = v1; }
                    else { u32x4 w; w.x = cvt_pk_bf16(v0[0], v0[1]); w.y = cvt_pk_bf16(v0[2], v0[3]); w.z = cvt_pk_bf16(v1[0], v1[1]); w.w = cvt_pk_bf16(v1[2], v1[3]); *(u32x4*)(rowp + bj * HALF * 2) = w; } } }
    }
};
struct EpiSwiGLU {
    static constexpr bool PERM = true, AFTER_DRAIN = false;
    bf16_t* O; int ldc; const float* ssp; float eps;
    __device__ __forceinline__ void operator()(const f32x4 (&acc)[2][2][4][2], const Unit& u, int wr, int wc, int fr, int fq) const {
        const int col0 = u.pn * HALF + wc * 32 + 8 * fq;
#pragma unroll
        for (int ai = 0; ai < 2; ++ai)
#pragma unroll
            for (int m = 0; m < 4; ++m) { const int row = u.pm * BM + ai * HALF + wr * 64 + m * 16 + fr; bf16_t* rowp = O + (size_t)row * ldc + col0;
                const float r = ssp ? row_rstd(ssp, row, eps) : 1.0f;
                const f32x4 g0 = acc[ai][0][m][0] * r, g1 = acc[ai][0][m][1] * r, u0 = acc[ai][1][m][0] * r, u1 = acc[ai][1][m][1] * r;
                u32x4 w; w.x = cvt_pk_bf16(swiglu_f(g0[0], u0[0]), swiglu_f(g0[1], u0[1])); w.y = cvt_pk_bf16(swiglu_f(g0[2], u0[2]), swiglu_f(g0[3], u0[3]));
                w.z = cvt_pk_bf16(swiglu_f(g1[0], u1[0]), swiglu_f(g1[1], u1[1])); w.w = cvt_pk_bf16(swiglu_f(g1[2], u1[2]), swiglu_f(g1[3], u1[3]));
                *(u32x4*)rowp = w; }
    }
};
struct EpiBf16Split {
    static constexpr bool PERM = true, AFTER_DRAIN = false;
    bf16_t* O; int ldc; int split_cols; size_t split_stride; const float* ssp; float eps;
    __device__ __forceinline__ void operator()(const f32x4 (&acc)[2][2][4][2], const Unit& u, int wr, int wc, int fr, int fq) const {
        int colt = u.pn * BM; const int t = colt / split_cols; bf16_t* base = O + (size_t)t * split_stride; colt -= t * split_cols;
        const int col0 = colt + wc * 32 + 8 * fq;
#pragma unroll
        for (int ai = 0; ai < 2; ++ai)
#pragma unroll
            for (int m = 0; m < 4; ++m) { const int row = u.pm * BM + ai * HALF + wr * 64 + m * 16 + fr; bf16_t* rowp = base + (size_t)row * ldc + col0; const float r = row_rstd(ssp, row, eps);
#pragma unroll
                for (int bj = 0; bj < 2; ++bj) { const f32x4 v0 = acc[ai][bj][m][0] * r, v1 = acc[ai][bj][m][1] * r; u32x4 w; w.x = cvt_pk_bf16(v0[0], v0[1]); w.y = cvt_pk_bf16(v0[2], v0[3]); w.z = cvt_pk_bf16(v1[0], v1[1]); w.w = cvt_pk_bf16(v1[2], v1[3]);
                    *(u32x4*)(rowp + bj * HALF) = w; } }
    }
};
struct EpiQKV {
    static constexpr bool PERM = true, AFTER_DRAIN = false;
    bf16_t* O; const float* gains;
    const float* tab;
    float qscale, eps;
    __device__ __forceinline__ void operator()(const f32x4 (&acc)[2][2][4][2], const Unit& u, int wr, int wc, int fr, int fq) const {
        const int tile = u.pn; int gsel = 0; bool ax = false; float sc = 1.f; bool plain = false;
        if (tile < 2) { gsel = 0; ax = false; sc = qscale; } else if (tile < 4) { gsel = 2; ax = true; sc = qscale; } else if (tile == 4) { if (wc < 2) { gsel = 1; ax = false; } else { gsel = 3; ax = true; } } else plain = true;
        bf16_t* obase = O + tile * 256 + wc * 64 + 8 * fq;
        if (plain) {
#pragma unroll
            for (int ai = 0; ai < 2; ++ai)
#pragma unroll
                for (int m = 0; m < 4; ++m) { bf16_t* rowp = obase + (size_t)(u.pm * BM + ai * HALF + wr * 64 + m * 16 + fr) * 1536;
#pragma unroll
                    for (int bj = 0; bj < 2; ++bj) { const f32x4 v0 = acc[ai][bj][m][0], v1 = acc[ai][bj][m][1]; u32x4 w; w.x = cvt_pk_bf16(v0[0], v0[1]); w.y = cvt_pk_bf16(v0[2], v0[3]); w.z = cvt_pk_bf16(v1[0], v1[1]); w.w = cvt_pk_bf16(v1[2], v1[3]);
                        *(u32x4*)(rowp + 32 * bj) = w; } }
            return;
        }
        const float* gp = gains + gsel * 64 + 8 * fq; const float* tabp = tab + (ax ? 2 * 8192 * 32 : 0);
        f32x4 ga[2][2];
#pragma unroll
        for (int bj = 0; bj < 2; ++bj)
#pragma unroll
            for (int n = 0; n < 2; ++n) ga[bj][n] = *(const f32x4*)(gp + 32 * bj + 4 * n);
#pragma unroll
        for (int ai = 0; ai < 2; ++ai)
#pragma unroll
            for (int m = 0; m < 4; ++m) {
                const int row = u.pm * BM + ai * HALF + wr * 64 + m * 16 + fr, t = row & 8191;
                f32x4 x1[2], x2[2]; x1[0] = acc[ai][0][m][0]; x1[1] = acc[ai][0][m][1]; x2[0] = acc[ai][1][m][0]; x2[1] = acc[ai][1][m][1];
                float ss = 0.f;
#pragma unroll
                for (int n = 0; n < 2; ++n)
#pragma unroll
                    for (int j = 0; j < 4; ++j) ss += x1[n][j] * x1[n][j] + x2[n][j] * x2[n][j];
                ss += __shfl_xor(ss, 16); ss += __shfl_xor(ss, 32);
                const float r = 1.0f / sqrtf(ss * (1.0f / 64.0f) + eps);
                const float* cp = tabp + (size_t)t * 32 + 8 * fq; const float* sp = cp + 8192 * 32;
                u32x4 w1, w2;
#pragma unroll
                for (int n = 0; n < 2; ++n) { const f32x4 c = *(const f32x4*)(cp + 4 * n), s = *(const f32x4*)(sp + 4 * n);
                    const f32x4 y1 = x1[n] * r * ga[0][n], y2 = x2[n] * r * ga[1][n];
                    const f32x4 o1 = (y1 * c - y2 * s) * sc, o2 = (y2 * c + y1 * s) * sc;
                    w1[2 * n] = cvt_pk_bf16(o1[0], o1[1]); w1[2 * n + 1] = cvt_pk_bf16(o1[2], o1[3]); w2[2 * n] = cvt_pk_bf16(o2[0], o2[1]); w2[2 * n + 1] = cvt_pk_bf16(o2[2], o2[3]); }
                bf16_t* rowp = obase + (size_t)row * 1536;
                *(u32x4*)rowp = w1; *(u32x4*)(rowp + 32) = w2;
            }
    }
};
__device__ __forceinline__ int moe_tail_parts(int T, int G, int maxsub) { const int lim = (G < maxsub ? G : maxsub); int P = 1;
    if (T * 2 <= lim) P = 2; if (T * 4 <= lim) P = 4; if (T * 7 <= lim) P = 7; if (T * 14 <= lim) P = 14; return T > 0 ? P : 1; }
struct MoeOrder {
    int nM, nN, nwg, G, c, ntk, R, T, P; int t0[9];
    __device__ __forceinline__ void init(const int* meta, int N, int G_, int c_, int K_, bool split, int maxsub) {
#pragma unroll
        for (int e = 0; e < 9; ++e) t0[e] = __builtin_amdgcn_readfirstlane(meta[e]) >> 8;
        nM = t0[8]; nN = N / BM; nwg = nM * nN; G = G_; c = c_; ntk = K_ / BK; R = nwg / G; T = nwg % G; P = split ? moe_tail_parts(T, G, maxsub) : 1; }
    __device__ __forceinline__ void unit_at(int L, Unit& u) const {
        int wgid = L; { const int q = nwg / NXCD, r = nwg % NXCD, xcd = wgid % NXCD, off = wgid / NXCD; wgid = (xcd < r ? xcd * (q + 1) : r * (q + 1) + (xcd - r) * q) + off; }
        const int nig = WGM * nN, gid = wgid / nig, fm = gid * WGM, gsz = (nM - fm) < WGM ? (nM - fm) : WGM;
        u.pm = fm + ((wgid % nig) % gsz); u.pn = (wgid % nig) / gsz; int e = 0;
#pragma unroll
        for (int k = 1; k < 8; ++k) e += (u.pm >= t0[k]) ? 1 : 0;
        u.e = e; u.k0 = 0; u.nt = ntk; u.part = -1; u.tix = 0; }
    __device__ __forceinline__ bool next(int i, Unit& u) const {
        if (i < R) { unit_at(i * G + c, u); return true; }
        if (i > R || c >= T * P) return false;
        const int tix = c / P, part = c % P; unit_at(R * G + tix, u);
        if (P > 1) { u.nt = ntk / P; u.k0 = part * u.nt; u.part = part; u.tix = tix; }
        return true;
    }
    __device__ __forceinline__ void a_ready(const Unit&) const {}
    __device__ __forceinline__ void done(const Unit&) const {}
};
template <class Epi, class Sched, bool ALIGN_EPI = false, bool SP2 = false>
__device__ __forceinline__ void gemm_phase(PG8_LAS unsigned char* lds, const Gemm g, const Sched& S, const Epi& E) {
    int tid = threadIdx.x; asm volatile("" : "+v"(tid));
    const int wid = __builtin_amdgcn_readfirstlane(tid >> 6), lane = tid & 63, wr = wid >> 2, wc = wid & 3, fr = lane & 15, fq = lane >> 4;
    const int K = g.K, nt = K / BK;
    unsigned voffA[2], voffB[2];
#pragma unroll
    for (int i = 0; i < 2; ++i) { int R, C; stage_rc(tid * 16 + i * 8192, R, C); const int Rb = Epi::PERM ? ((R & ~31) + perm32(R & 31)) : R;
        voffA[i] = (unsigned)(R * K + C) * 2u; voffB[i] = (unsigned)(Rb * K + C) * 2u; }
    const size_t kstep = (size_t)(BK * 2);
    const size_t hstep = (size_t)HALF * K * 2;
    const size_t tstep = 2 * hstep;
    const unsigned ldsw = (unsigned)wid * 1024u;
    const int aoff = lds_byte(wr * 64 + fr, fq * 8), boff = lds_byte(wc * 32 + fr, fq * 8);
#define PG8_SA(b, h) (((b) * 2 + (h)) * HTB)
#define PG8_SB(b, h) ((4 + (b) * 2 + (h)) * HTB)
#define PG8_STAGE(bufoff, gbase, voff) do { _Pragma("unroll") for (int _i = 0; _i < 2; ++_i) \
        __builtin_amdgcn_global_load_lds((const unsigned*)((const char*)(gbase) + (voff)[_i]), (PG8_LAS unsigned*)(lds + (bufoff) + ldsw + _i * 8192), 16, 0, 0); } while (0)
#define PG8_LDA(dst, b, h) do { _Pragma("unroll") for (int m = 0; m < 4; ++m) _Pragma("unroll") for (int k = 0; k < 2; ++k) dst[m][k] = *(const PG8_LAS bf16x8*)(lds + PG8_SA(b, h) + aoff + m * 2048 + k * 1024); } while (0)
#define PG8_LDB(dst, b, h) do { _Pragma("unroll") for (int n = 0; n < 2; ++n) _Pragma("unroll") for (int k = 0; k < 2; ++k) dst[n][k] = *(const PG8_LAS bf16x8*)(lds + PG8_SB(b, h) + boff + n * 2048 + k * 1024); } while (0)
#define PG8_MMA(ai, bj, At, Bt) do { __builtin_amdgcn_s_setprio(1); _Pragma("unroll") for (int m = 0; m < 4; ++m) _Pragma("unroll") for (int n = 0; n < 2; ++n) _Pragma("unroll") for (int k = 0; k < 2; ++k) \
        acc[ai][bj][m][n] = __builtin_amdgcn_mfma_f32_16x16x32_bf16(Bt[n][k], At[m][k], acc[ai][bj][m][n], 0, 0, 0); __builtin_amdgcn_s_setprio(0); } while (0)
#define PG8_WAIT_V(n) asm volatile("s_waitcnt vmcnt(" #n ")" ::: "memory")
#define PG8_WAIT_L(n) asm volatile("s_waitcnt lgkmcnt(" #n ")" ::: "memory")
#define PG8_BAR __builtin_amdgcn_s_barrier()
#define PG8_SCHED __builtin_amdgcn_sched_barrier(0)
    Unit cur, nxt; int ui = 0;
    if (!S.next(0, cur)) return;
    f32x4 acc[2][2][4][2];
#pragma unroll
    for (int a = 0; a < 2; ++a)
#pragma unroll
        for (int b = 0; b < 2; ++b)
#pragma unroll
            for (int m = 0; m < 4; ++m)
#pragma unroll
                for (int n = 0; n < 2; ++n) acc[a][b][m][n] = (f32x4){0.f, 0.f, 0.f, 0.f};
    bf16x8 At[4][2], B0[2][2], B1[2][2];
    const char* cA = (const char*)g.A + (size_t)cur.pm * tstep + (size_t)cur.k0 * kstep; const char* cB = (const char*)g.Bt + (size_t)cur.e * g.estride + (cur.e >= g.esplit ? g.edelta : 0ll) + (size_t)cur.pn * tstep + (size_t)cur.k0 * kstep;
    int cnt = cur.nt;
    S.a_ready(cur);
    if constexpr (SP2) {
        PG8_STAGE(PG8_SB(0, 0), cB, voffB); PG8_STAGE(PG8_SB(0, 1), cB + hstep, voffB); PG8_STAGE(PG8_SA(0, 0), cA, voffA); PG8_STAGE(PG8_SA(0, 1), cA + hstep, voffA);
        if (wr == 1) PG8_BAR;
        PG8_WAIT_V(2); PG8_BAR;
        PG8_STAGE(PG8_SB(1, 0), cB + kstep, voffB); PG8_STAGE(PG8_SA(1, 0), cA + kstep, voffA); PG8_STAGE(PG8_SB(1, 1), cB + hstep + kstep, voffB);
        PG8_WAIT_V(6); PG8_BAR;
    } else {
        PG8_STAGE(PG8_SB(0, 0), cB, voffB); PG8_STAGE(PG8_SA(0, 0), cA, voffA); PG8_STAGE(PG8_SB(0, 1), cB + hstep, voffB); PG8_STAGE(PG8_SA(0, 1), cA + hstep, voffA);
        if (wr == 1) PG8_BAR;
        PG8_WAIT_V(4); PG8_BAR;
        PG8_STAGE(PG8_SB(1, 0), cB + kstep, voffB); PG8_STAGE(PG8_SA(1, 0), cA + kstep, voffA); PG8_STAGE(PG8_SB(1, 1), cB + hstep + kstep, voffB);
        PG8_WAIT_V(6); PG8_BAR;
    }
    for (;;) {
        const bool has_next = S.next(ui + 1, nxt);
        const char* nA = has_next ? (const char*)g.A + (size_t)nxt.pm * tstep + (size_t)nxt.k0 * kstep : cA; const char* nB = has_next ? (const char*)g.Bt + (size_t)nxt.e * g.estride + (nxt.e >= g.esplit ? g.edelta : 0ll) + (size_t)nxt.pn * tstep + (size_t)nxt.k0 * kstep : cB;
        for (int t = 0; t < cnt; t += 2) {
            const bool last = (t == cnt - 2);
            const char* a1 = cA + (size_t)(t + 1) * kstep;
            const char* a2 = last ? nA : cA + (size_t)(t + 2) * kstep; const char* b2 = last ? nB : cB + (size_t)(t + 2) * kstep;
            const char* a3 = a2 + kstep; const char* b3 = b2 + kstep;
            if (last && has_next) S.a_ready(nxt);
            if constexpr (SP2) {
            PG8_LDB(B0, 0, 0); PG8_LDB(B1, 0, 1); PG8_SCHED; PG8_LDA(At, 0, 0); PG8_STAGE(PG8_SA(1, 1), a1 + hstep, voffA);
            PG8_WAIT_V(8); PG8_WAIT_L(0); PG8_BAR; PG8_MMA(0, 0, At, B0); PG8_MMA(0, 1, At, B1); PG8_BAR; PG8_SCHED;
            PG8_LDA(At, 0, 1); PG8_STAGE(PG8_SB(0, 0), b2, voffB); PG8_STAGE(PG8_SB(0, 1), b2 + hstep, voffB); PG8_STAGE(PG8_SA(0, 0), a2, voffA);
            PG8_WAIT_V(8); PG8_WAIT_L(0); PG8_BAR; PG8_MMA(1, 0, At, B0); PG8_MMA(1, 1, At, B1); PG8_BAR; PG8_SCHED;
            PG8_LDB(B0, 1, 0); PG8_LDB(B1, 1, 1); PG8_SCHED; PG8_LDA(At, 1, 0); PG8_STAGE(PG8_SA(0, 1), a2 + hstep, voffA);
            PG8_WAIT_V(8); PG8_WAIT_L(0); PG8_BAR; PG8_MMA(0, 0, At, B0); PG8_MMA(0, 1, At, B1); PG8_BAR; PG8_SCHED;
            PG8_LDA(At, 1, 1); PG8_STAGE(PG8_SB(1, 0), b3, voffB); PG8_STAGE(PG8_SB(1, 1), b3 + hstep, voffB); PG8_STAGE(PG8_SA(1, 0), a3, voffA);
            PG8_WAIT_V(8); PG8_WAIT_L(0); PG8_BAR; PG8_MMA(1, 0, At, B0); PG8_MMA(1, 1, At, B1); PG8_BAR; PG8_SCHED;
            } else {
            PG8_LDB(B0, 0, 0); PG8_SCHED; PG8_LDA(At, 0, 0); PG8_STAGE(PG8_SA(1, 1), a1 + hstep, voffA);
            PG8_WAIT_L(8); PG8_BAR; PG8_WAIT_L(0); PG8_MMA(0, 0, At, B0); PG8_BAR; PG8_SCHED;
            PG8_LDB(B1, 0, 1); PG8_STAGE(PG8_SB(0, 0), b2, voffB);
            PG8_BAR; PG8_WAIT_L(0); PG8_MMA(0, 1, At, B1); PG8_BAR;
            PG8_LDA(At, 0, 1); PG8_STAGE(PG8_SA(0, 0), a2, voffA);
            PG8_BAR; PG8_WAIT_L(0); PG8_MMA(1, 0, At, B0); PG8_BAR; PG8_SCHED;
            PG8_STAGE(PG8_SB(0, 1), b2 + hstep, voffB);
            PG8_WAIT_V(6); PG8_BAR; PG8_MMA(1, 1, At, B1); PG8_BAR;
            PG8_LDB(B0, 1, 0); PG8_SCHED; PG8_LDA(At, 1, 0); PG8_STAGE(PG8_SA(0, 1), a2 + hstep, voffA);
            PG8_WAIT_L(8); PG8_BAR; PG8_WAIT_L(0); PG8_MMA(0, 0, At, B0); PG8_BAR; PG8_SCHED;
            PG8_LDB(B1, 1, 1); PG8_STAGE(PG8_SB(1, 0), b3, voffB);
            PG8_BAR; PG8_WAIT_L(0); PG8_MMA(0, 1, At, B1); PG8_BAR;
            PG8_LDA(At, 1, 1); PG8_STAGE(PG8_SA(1, 0), a3, voffA);
            PG8_BAR; PG8_WAIT_L(0); PG8_MMA(1, 0, At, B0); PG8_BAR; PG8_SCHED;
            PG8_STAGE(PG8_SB(1, 1), b3 + hstep, voffB);
            PG8_WAIT_V(6); PG8_BAR; PG8_MMA(1, 1, At, B1); PG8_BAR;
            }
        }
        if constexpr (ALIGN_EPI) { if (wr == 0) PG8_BAR; }
        if constexpr (!Epi::AFTER_DRAIN) { E(acc, cur, wr, wc, fr, fq); S.done(cur); }
        if (!has_next) break;
#pragma unroll
        for (int a = 0; a < 2; ++a)
#pragma unroll
            for (int b = 0; b < 2; ++b)
#pragma unroll
                for (int m = 0; m < 4; ++m)
#pragma unroll
                    for (int n = 0; n < 2; ++n) acc[a][b][m][n] = (f32x4){0.f, 0.f, 0.f, 0.f};
        cur = nxt; cA = nA; cB = nB; cnt = cur.nt; ++ui;
        if constexpr (ALIGN_EPI) { if (wr == 1) PG8_BAR; }
    }
    PG8_WAIT_V(0);
    if constexpr (!ALIGN_EPI) { if (wr == 0) PG8_BAR; }
    PG8_BAR;
    if constexpr (Epi::AFTER_DRAIN) { E.fused(acc, cur, wr, wc, fr, fq, lds, wid, lane); S.done(cur); }
#undef PG8_SA
#undef PG8_SB
#undef PG8_STAGE
#undef PG8_LDA
#undef PG8_LDB
#undef PG8_MMA
#undef PG8_WAIT_V
#undef PG8_WAIT_L
#undef PG8_BAR
#undef PG8_SCHED
}
}

#ifndef PG8_SP2
#define PG8_SP2 true
#endif
#ifndef PG8_ALIGN
#define PG8_ALIGN true
#endif
#include <hip/hip_bf16.h>
#include <cmath>
namespace attn_body {
using bf16=__hip_bfloat16;
using bf16x8=__attribute__((ext_vector_type(8)))short;
using s16x4=__attribute__((ext_vector_type(4)))short;
using f32x16=__attribute__((ext_vector_type(16)))float;
using u32x4=__attribute__((ext_vector_type(4)))unsigned;
constexpr int SEQ=8192,D=64,QP=1536,OP=1024;
constexpr int NW=8,QBLK=32,QB=QBLK*NW,KVBLK=64,NQB=SEQ/QB;
constexpr int ATTN_UNIT_ROWS=QB;
__device__ __forceinline__ int crow(int r,int hi){return (r&3)+8*(r>>2)+4*hi;}
#define SBAR() __builtin_amdgcn_sched_barrier(0)
__device__ __forceinline__ void wmask(f32x16&p0,f32x16&p1,int dq,int hi){
  const float NEG=-INFINITY; const int d0=dq-4*hi;
  #pragma unroll
  for(int r=0;r<16;++r){const int rel=d0-((r&3)+8*(r>>2)); if(rel>128||rel<-128)p0[r]=NEG; if(rel-32>128||rel-32<-128)p1[r]=NEG;}
}
constexpr int NSLOT=3, SLOTB=8192;
constexpr int LDS_K=0, LDS_V=NSLOT*SLOTB, LDS_WS=2*NSLOT*SLOTB, LDS_OST=LDS_WS+NW*64*4, LDS_BYTES=LDS_OST+NW*4096;
constexpr float C2=0.125f*1.4426950408889634f;
template<int OFF> __device__ __forceinline__ void glds16(const void*sbase,unsigned voff,unsigned lds_dst){unsigned keep;
  asm volatile("s_mov_b32 %0, m0\n\ts_mov_b32 m0, %3\n\ts_nop 0\n\tglobal_load_lds_dwordx4 %1, %2 offset:%c4\n\ts_mov_b32 m0, %0":"=&s"(keep):"v"(voff),"s"(sbase),"s"(lds_dst),"i"(OFF):"memory");}
__device__ __forceinline__ float max3f(float a,float b,float c){float r;asm("v_max3_f32 %0, %1, %2, %3":"=v"(r):"v"(a),"v"(b),"v"(c));return r;}
__device__ __forceinline__ float max2f(float a,float b){float r;asm("v_max_f32_e32 %0, %1, %2":"=v"(r):"v"(a),"v"(b));return r;}
__device__ __forceinline__ float fadd_s(float a,float b){float r;asm("v_add_f32_e32 %0, %1, %2":"=v"(r):"v"(a),"v"(b));return r;}
__device__ __forceinline__ float fsub_s(float a,float b){float r;asm("v_sub_f32_e32 %0, %1, %2":"=v"(r):"v"(a),"v"(b));return r;}
typedef float f32x2_t __attribute__((ext_vector_type(2))); typedef __bf16 bf16x2_t __attribute__((ext_vector_type(2)));
__device__ __forceinline__ unsigned cvtpk_s(float lo,float hi){f32x2_t v={lo,hi};bf16x2_t b=__builtin_convertvector(v,bf16x2_t);return __builtin_bit_cast(unsigned,b);}
#define WAIT_BAR(N) asm volatile("s_waitcnt vmcnt(" #N ") lgkmcnt(0)\n\ts_barrier":::"memory")

__device__ __forceinline__ void qkt(f32x16&p0,f32x16&p1,const char*Kslot,const bf16x8*qr,const f32x16&negm,int r32,int hi){
  const char*kb=Kslot+hi*1024+r32*16;
  #pragma unroll
  for(int d0=0;d0<4;++d0){
    const bf16x8 b0=*reinterpret_cast<const bf16x8*>(kb+d0*2048);
    const bf16x8 b1=*reinterpret_cast<const bf16x8*>(kb+d0*2048+512);
    if(d0==0){p0=__builtin_amdgcn_mfma_f32_32x32x16_bf16(b0,qr[0],negm,0,0,0);p1=__builtin_amdgcn_mfma_f32_32x32x16_bf16(b1,qr[0],negm,0,0,0);}
    else{p0=__builtin_amdgcn_mfma_f32_32x32x16_bf16(b0,qr[d0],p0,0,0,0);p1=__builtin_amdgcn_mfma_f32_32x32x16_bf16(b1,qr[d0],p1,0,0,0);}}
}
typedef __attribute__((address_space(3))) const char* lds_cptr;
typedef short v4i16_t __attribute__((ext_vector_type(4)));
__device__ __forceinline__ void kload8(bf16x8*kf,lds_cptr kp){
  kf[0]=*(const __attribute__((address_space(3))) bf16x8*)(kp);      kf[1]=*(const __attribute__((address_space(3))) bf16x8*)(kp+512);
  kf[2]=*(const __attribute__((address_space(3))) bf16x8*)(kp+2048); kf[3]=*(const __attribute__((address_space(3))) bf16x8*)(kp+2560);
  kf[4]=*(const __attribute__((address_space(3))) bf16x8*)(kp+4096); kf[5]=*(const __attribute__((address_space(3))) bf16x8*)(kp+4608);
  kf[6]=*(const __attribute__((address_space(3))) bf16x8*)(kp+6144); kf[7]=*(const __attribute__((address_space(3))) bf16x8*)(kp+6656);
}
__device__ __forceinline__ void kload2(bf16x8*kf,lds_cptr kp,int j){ kf[2*j]=*(const __attribute__((address_space(3))) bf16x8*)(kp+j*2048); kf[2*j+1]=*(const __attribute__((address_space(3))) bf16x8*)(kp+j*2048+512); }
__device__ __forceinline__ s16x4 vtr(lds_cptr p){ return __builtin_bit_cast(s16x4,__builtin_amdgcn_ds_read_tr16_b64_v4i16((__attribute__((address_space(3))) v4i16_t*)p)); }
__device__ __forceinline__ float rowmax(const f32x16&p0,const f32x16&p1){
  float a=max3f(p0[0],p0[1],p1[0]),b=max3f(p0[2],p0[3],p1[1]);a=max3f(a,p1[2],p1[3]);
  #pragma unroll
  for(int r=4;r<16;r+=4){a=max3f(a,p0[r],p0[r+1]);b=max3f(b,p0[r+2],p0[r+3]);a=max3f(a,p1[r],p1[r+1]);b=max3f(b,p1[r+2],p1[r+3]);}
  const float m=max2f(a,b);
  auto rr=__builtin_amdgcn_permlane32_swap(__float_as_uint(m),__float_as_uint(m),false,false);
  return max2f(__uint_as_float(rr[0]),__uint_as_float(rr[1]));
}
__device__ __forceinline__ void pv(f32x16*o,int vb,bf16x8 pa0,bf16x8 pa1,bf16x8 pa2,bf16x8 pa3){
  #pragma unroll
  for(int d0=0;d0<2;++d0){s16x4 lo[4],hi[4];
    #pragma unroll
    for(int ks=0;ks<4;++ks){
      asm volatile("ds_read_b64_tr_b16 %0,%1 offset:%c2":"=&v"(lo[ks]):"v"(vb),"i"(d0*4096+ks*1024):"memory");
      asm volatile("ds_read_b64_tr_b16 %0,%1 offset:%c2":"=&v"(hi[ks]):"v"(vb),"i"(d0*4096+ks*1024+512):"memory");}
    asm volatile("s_waitcnt lgkmcnt(0)":::"memory");SBAR();
    #define PK(k) (bf16x8){lo[k][0],lo[k][1],lo[k][2],lo[k][3],hi[k][0],hi[k][1],hi[k][2],hi[k][3]}
    o[d0]=__builtin_amdgcn_mfma_f32_32x32x16_bf16(pa0,PK(0),o[d0],0,0,0);
    o[d0]=__builtin_amdgcn_mfma_f32_32x32x16_bf16(pa1,PK(1),o[d0],0,0,0);
    o[d0]=__builtin_amdgcn_mfma_f32_32x32x16_bf16(pa2,PK(2),o[d0],0,0,0);
    o[d0]=__builtin_amdgcn_mfma_f32_32x32x16_bf16(pa3,PK(3),o[d0],0,0,0);
    #undef PK
  }
}

#ifndef ATTN_STORE16
#define ATTN_STORE16(p,v) (*(u32x4*)(p)=(v))
#endif
template<int THRL,int MODE> __device__ __forceinline__ void attn_unit(int b,int q0,int kfirst,int NT,int qcol,int kcol,int vcol,int ocol,float sink2,const bf16*QKVp,bf16*O,char*shm){
  int tid=threadIdx.x; asm volatile("":"+v"(tid)); const int lane=tid&63,r32=lane&31,hi=lane>>5; const int wid=__builtin_amdgcn_readfirstlane(tid>>6);
  const long rowbase=(long)b*SEQ;
  const bf16*Qw=QKVp+(rowbase+q0+wid*QBLK)*QP+qcol;
  const char*Kh=(const char*)(QKVp+(rowbase+kfirst)*QP+kcol);
  const unsigned lds0=(unsigned)(uintptr_t)shm;
  float*wsf=(float*)(shm+LDS_WS)+wid*64;
  const unsigned ksrc=(unsigned)(lane*QP+wid*8)*2u;
  const unsigned vsrc=(unsigned)((16*(wid&3)+(lane>>2))*QP+(wid>>2)*32+(lane&3)*8)*2u;
  const unsigned kdst=lds0+LDS_K+wid*1024, vdst=lds0+LDS_V+wid*1024;
  #define DMA_K(t,slot) glds16<0>(Kh+(long)(t)*(KVBLK*QP*2),ksrc,(unsigned)__builtin_amdgcn_readfirstlane(kdst+(slot)))
  #define DMA_V(t,slot) glds16<0>(Kh+512+(long)(t)*(KVBLK*QP*2),vsrc,(unsigned)__builtin_amdgcn_readfirstlane(vdst+(slot)))
  const int vb0=(int)(lds0+LDS_V)+((lane>>4)&1)*32+(lane&3)*8+(4*hi+((lane&15)>>2))*64;
  const char*Kbase=shm+LDS_K; bf16x8 kf[8];
  const lds_cptr shm3=(lds_cptr)shm; const lds_cptr kp0=shm3+LDS_K+hi*1024+r32*16; const lds_cptr vp0=shm3+LDS_V+((lane>>4)&1)*32+(lane&3)*8+(4*hi+((lane&15)>>2))*64;
  DMA_K(0,0);DMA_V(0,0);DMA_K(1,SLOTB);
  bf16x8 qr[4];
  #pragma unroll
  for(int d0=0;d0<4;++d0)qr[d0]=*reinterpret_cast<const bf16x8*>(&Qw[(long)r32*QP+d0*16+hi*8]);
  float mhat=0.f;f32x16 o[2];o[0]=f32x16{};o[1]=f32x16{};f32x16 negm=f32x16{};
  f32x16 lacc=f32x16{}; const bf16x8 ones={(short)0x3F80,(short)0x3F80,(short)0x3F80,(short)0x3F80,(short)0x3F80,(short)0x3F80,(short)0x3F80,(short)0x3F80}; if(MODE==0){asm volatile("":"+v"(negm));}
  const int dq0=q0+wid*QBLK+r32-kfirst;
  #define CMASK(P0,P1,t) do{ if(MODE==1) wmask(P0,P1,dq0-64*(t),hi); }while(0)
  bool resc=false;
  #define START(P0,P1) do{ const float rm=rowmax(P0,P1); resc=false; \
    { const float dl=(MODE==1)?__builtin_fmaxf(rm,-64.f):rm; mhat=fadd_s(mhat,dl); \
      _Pragma("unroll") for(int r=0;r<16;++r){P0[r]=fsub_s(P0[r],dl);P1[r]=fsub_s(P1[r],dl);} \
      if(MODE==0){ _Pragma("unroll") for(int r=0;r<16;++r)negm[r]=-mhat; asm volatile("":"+v"(negm)); } } \
    _Pragma("unroll") for(int r=0;r<16;++r)P0[r]=__builtin_amdgcn_exp2f(P0[r]); }while(0)
  #define RESC() do{ if(resc){ asm volatile("s_waitcnt lgkmcnt(0)":::"memory"); \
      _Pragma("unroll") for(int d_=0;d_<2;++d_) _Pragma("unroll") for(int r=0;r<16;++r)o[d_][r]*=wsf[crow(r,hi)]; \
      _Pragma("unroll") for(int r=0;r<16;++r)lacc[r]*=wsf[crow(r,hi)]; } }while(0)
  f32x16 pA0,pA1,pB0,pB1;
  int sl_prev=0,sl_cur=0,sl_next=SLOTB;
  #define ROT() do{sl_prev=sl_cur;sl_cur=sl_next;sl_next=(sl_next==(NSLOT-1)*SLOTB)?0:sl_next+SLOTB;}while(0)
  DMA_K(2,2*SLOTB);
  WAIT_BAR(3);
  qkt(pA0,pA1,Kbase,qr,negm,r32,hi);asm volatile("s_nop 15\n\ts_nop 7":"+v"(pA0),"+v"(pA1));CMASK(pA0,pA1,0);
  START(pA0,pA1);
  _Pragma("unroll") for(int r=0;r<16;++r)pA1[r]=__builtin_amdgcn_exp2f(pA1[r]);
  WAIT_BAR(0);
  DMA_K(3,0);DMA_V(1,SLOTB);
  ROT();
  kload8(kf,kp0+sl_cur);
  WAIT_BAR(2);
  s16x4 vlo[8],vhi[8]; u32x4 pw0,pw1,pw2,pw3;
  #define PKW(P,B) cvtpk_s(P[B],P[B+1])
  #define PAF(k) __builtin_bit_cast(bf16x8,pw##k)
  #define VFR(i) (bf16x8){vlo[i][0],vlo[i][1],vlo[i][2],vlo[i][3],vhi[i][0],vhi[i][1],vhi[i][2],vhi[i][3]}
  #define PIN(x) asm volatile("":"+v"(x))
  #define MX3(a,b,c) __builtin_fmaxf(__builtin_fmaxf((a),(b)),(c))
  #define GAPA(MF,A0,A1,A2,A3,W0,W1,PW) do{ MF; W0; W1; PIN(PW); SBAR(); }while(0)
  #define EX(v) __builtin_amdgcn_exp2f(v)
  #define GAPB(MF,X,B) do{ MF; X[B]=EX(X[B]); X[B+1]=EX(X[B+1]); X[B+2]=EX(X[B+2]); X[B+3]=EX(X[B+3]); PIN(X); SBAR(); }while(0)
  #define VRD(i) do{ vlo[i]=vtr(vp_+(((i)>>2)*4096+((i)&3)*1024)); vhi[i]=vtr(vp_+(((i)>>2)*4096+((i)&3)*1024+512)); }while(0)
  #define KRD(G,j) do{ if(G){ kload2(kf,kp0+sl_next,j); SBAR(); } }while(0)
  #define STEP(C0,C1,P0,P1,t,GK,GV,GL) do{ SBAR(); \
    const lds_cptr vp_=vp0+sl_prev; \
    VRD(0); SBAR(); \
    GAPA(C0=__builtin_amdgcn_mfma_f32_32x32x16_bf16(kf[0],qr[0],negm,0,0,0), P0[2],P0[3],P0[4],P0[5],     pw0[0]=PKW(P0,0), pw0[1]=PKW(P0,2), pw0); \
    VRD(4); SBAR(); GAPA(C1=__builtin_amdgcn_mfma_f32_32x32x16_bf16(kf[1],qr[0],negm,0,0,0), P0[6],P0[7],P0[8],P0[9],     pw0[2]=PKW(P0,4), pw0[3]=PKW(P0,6), pw0); \
    VRD(1); SBAR(); GAPA(C0=__builtin_amdgcn_mfma_f32_32x32x16_bf16(kf[2],qr[1],C0,0,0,0),   P0[10],P0[11],P0[12],P0[13], pw1[0]=PKW(P0,8), pw1[1]=PKW(P0,10), pw1); \
    VRD(5); SBAR(); GAPA(C1=__builtin_amdgcn_mfma_f32_32x32x16_bf16(kf[3],qr[1],C1,0,0,0),   P0[14],P0[15],P1[0],P1[1],   pw1[2]=PKW(P0,12),pw1[3]=PKW(P0,14), pw1); \
    VRD(2); SBAR(); GAPA(C0=__builtin_amdgcn_mfma_f32_32x32x16_bf16(kf[4],qr[2],C0,0,0,0),   P1[2],P1[3],P1[4],P1[5],     pw2[0]=PKW(P1,0), pw2[1]=PKW(P1,2), pw2); \
    VRD(6); SBAR(); GAPA(C1=__builtin_amdgcn_mfma_f32_32x32x16_bf16(kf[5],qr[2],C1,0,0,0),   P1[6],P1[7],P1[8],P1[9],     pw2[2]=PKW(P1,4), pw2[3]=PKW(P1,6), pw2); \
    VRD(3); SBAR(); GAPA(C0=__builtin_amdgcn_mfma_f32_32x32x16_bf16(kf[6],qr[3],C0,0,0,0),   P1[10],P1[11],P1[12],P1[13], pw3[0]=PKW(P1,8), pw3[1]=PKW(P1,10), pw3); \
    VRD(7); SBAR(); GAPA(C1=__builtin_amdgcn_mfma_f32_32x32x16_bf16(kf[7],qr[3],C1,0,0,0),   P1[14],P1[15],0.f,0.f,       pw3[2]=PKW(P1,12),pw3[3]=PKW(P1,14), pw3); \
    lacc=__builtin_amdgcn_mfma_f32_32x32x16_bf16(PAF(0),ones,lacc,0,0,0); lacc=__builtin_amdgcn_mfma_f32_32x32x16_bf16(PAF(1),ones,lacc,0,0,0); \
    lacc=__builtin_amdgcn_mfma_f32_32x32x16_bf16(PAF(2),ones,lacc,0,0,0); lacc=__builtin_amdgcn_mfma_f32_32x32x16_bf16(PAF(3),ones,lacc,0,0,0); \
    if(GK){DMA_K((t)+3,sl_cur);} if(GV){DMA_V((t)+1,sl_next);} \
    if(MODE==1){ _Pragma("unroll") for(int r=0;r<16;++r){C0[r]-=mhat;C1[r]-=mhat;} } \
    CMASK(C0,C1,t); \
    { float a=MX3(C0[0],C0[1],C1[0]),b=MX3(C0[2],C0[3],C1[1]); a=MX3(a,C1[2],C1[3]); \
      _Pragma("unroll") for(int r=4;r<16;r+=4){a=MX3(a,C0[r],C0[r+1]);b=MX3(b,C0[r+2],C0[r+3]);a=MX3(a,C1[r],C1[r+1]);b=MX3(b,C1[r+2],C1[r+3]);} \
      float rm=__builtin_fmaxf(a,b); { auto rr=__builtin_amdgcn_permlane32_swap(__float_as_uint(rm),__float_as_uint(rm),false,false); rm=__builtin_fmaxf(__uint_as_float(rr[0]),__uint_as_float(rr[1])); } \
      resc=false; \
      if(__builtin_expect(__any(rm>(float)THRL),0)){ const float dl=__builtin_fmaxf(rm,0.f); mhat+=dl; \
        _Pragma("unroll") for(int r=0;r<16;++r){C0[r]-=dl;C1[r]-=dl;} \
        if(MODE==0){ _Pragma("unroll") for(int r=0;r<16;++r)negm[r]=-mhat; asm volatile("":"+v"(negm)); } \
        const float f=__builtin_amdgcn_exp2f(-dl); if(hi==0)wsf[r32]=f; resc=true; } } \
    SBAR(); \
    GAPB(o[0]=__builtin_amdgcn_mfma_f32_32x32x16_bf16(PAF(0),VFR(0),o[0],0,0,0), C0,0); \
    GAPB(o[1]=__builtin_amdgcn_mfma_f32_32x32x16_bf16(PAF(0),VFR(4),o[1],0,0,0), C0,4); \
    KRD(GL,0); GAPB(o[0]=__builtin_amdgcn_mfma_f32_32x32x16_bf16(PAF(1),VFR(1),o[0],0,0,0), C0,8); \
    KRD(GL,1); GAPB(o[1]=__builtin_amdgcn_mfma_f32_32x32x16_bf16(PAF(1),VFR(5),o[1],0,0,0), C0,12); \
    KRD(GL,2); GAPB(o[0]=__builtin_amdgcn_mfma_f32_32x32x16_bf16(PAF(2),VFR(2),o[0],0,0,0), C1,0); \
    KRD(GL,3); GAPB(o[1]=__builtin_amdgcn_mfma_f32_32x32x16_bf16(PAF(2),VFR(6),o[1],0,0,0), C1,4); \
    GAPB(o[0]=__builtin_amdgcn_mfma_f32_32x32x16_bf16(PAF(3),VFR(3),o[0],0,0,0), C1,8); \
    GAPB(o[1]=__builtin_amdgcn_mfma_f32_32x32x16_bf16(PAF(3),VFR(7),o[1],0,0,0), C1,12); \
    }while(0)
  int t=1;
  for(;t+5<NT;t+=2){
    STEP(pB0,pB1,pA0,pA1,t,true,true,true);     WAIT_BAR(2); RESC(); ROT();
    STEP(pA0,pA1,pB0,pB1,t+1,true,true,true);   WAIT_BAR(2); RESC(); ROT();
  }
  #define ENDW(tt) do{ if((tt)+3<NT){WAIT_BAR(2);} else if((tt)+2<NT){WAIT_BAR(1);} else {WAIT_BAR(0);} }while(0)
  for(;t+1<NT;t+=2){
    STEP(pB0,pB1,pA0,pA1,t,(t+3<NT),(t+1<NT),(t+1<NT));       ENDW(t);   RESC(); ROT();
    STEP(pA0,pA1,pB0,pB1,t+1,(t+4<NT),(t+2<NT),(t+2<NT));     ENDW(t+1); RESC(); ROT();
  }
  STEP(pB0,pB1,pA0,pA1,NT-1,false,false,false); RESC();
  {
    pw0=(u32x4){PKW(pB0,0),PKW(pB0,2),PKW(pB0,4),PKW(pB0,6)};pw1=(u32x4){PKW(pB0,8),PKW(pB0,10),PKW(pB0,12),PKW(pB0,14)};pw2=(u32x4){PKW(pB1,0),PKW(pB1,2),PKW(pB1,4),PKW(pB1,6)};pw3=(u32x4){PKW(pB1,8),PKW(pB1,10),PKW(pB1,12),PKW(pB1,14)};
    lacc=__builtin_amdgcn_mfma_f32_32x32x16_bf16(PAF(0),ones,lacc,0,0,0); lacc=__builtin_amdgcn_mfma_f32_32x32x16_bf16(PAF(1),ones,lacc,0,0,0);
    lacc=__builtin_amdgcn_mfma_f32_32x32x16_bf16(PAF(2),ones,lacc,0,0,0); lacc=__builtin_amdgcn_mfma_f32_32x32x16_bf16(PAF(3),ones,lacc,0,0,0);
    SBAR(); pv(o,vb0+sl_cur,PAF(0),PAF(1),PAF(2),PAF(3)); }
  #undef PKW
  #undef PAF
  #undef VFR
  #undef PIN
  #undef MX3
  #undef GAPA
  #undef GAPB
  #undef EX
  #undef VRD
  #undef KRD
  #undef STEP
  #undef ENDW
  float rli[16];
  if(MODE==1){ if(hi==0)wsf[32+r32]=__builtin_amdgcn_exp2f(sink2-mhat); asm volatile("s_waitcnt lgkmcnt(0)":::"memory");
    #pragma unroll
    for(int r=0;r<16;++r)rli[r]=__builtin_amdgcn_rcpf(lacc[r]+wsf[32+crow(r,hi)]); }
  else{
    #pragma unroll
    for(int r=0;r<16;++r)rli[r]=__builtin_amdgcn_rcpf(lacc[r]); }
  bf16*Ow=O+(rowbase+q0+wid*QBLK)*OP+ocol;
  { bf16*stg=(bf16*)(shm+LDS_OST)+wid*2048;
    #pragma unroll
    for(int r=0;r<16;++r){const int orow=crow(r,hi);
      #pragma unroll
      for(int d0=0;d0<2;++d0)stg[orow*64+d0*32+r32]=__float2bfloat16(o[d0][r]*rli[r]);}
    asm volatile("s_waitcnt lgkmcnt(0)":::"memory");
    #pragma unroll
    for(int i=0;i<4;++i){const int row=i*8+(lane>>3),ch=lane&7; const u32x4 v=*(const u32x4*)(stg+row*64+ch*8); ATTN_STORE16(Ow+(long)row*OP+ch*8,v);} }
  asm volatile("s_waitcnt lgkmcnt(0)\n\ts_barrier":::"memory");
  #undef DMA_K
  #undef DMA_V
  #undef CMASK
  #undef START
  #undef RESC
  #undef ROT
}
constexpr int ATTN_LDS_BYTES=LDS_BYTES;
template<int THRL=8> __device__ __forceinline__ void attn_phase(char*lds,const bf16*QKVp,bf16*O,const float*sink,int vcu,int G,int sel){
  if(sel&1) for(int u=2*vcu;u<512;u+=2*G){
    #pragma unroll 1
    for(int i=0;i<2;++i){ const int uu=u+i,g=uu>>7,b=g>>1,kvh=g&1,hq=(uu>>5)&3,qb=uu&31,h=4*kvh+hq;
      attn_unit<THRL,0>(b,qb*QB,0,SEQ/KVBLK,512+64*h,1024+64*(2+kvh),1280+64*(2+kvh),64*(8+h),0.f,QKVp,O,lds); }
  }
  if(sel&2) for(int u=2*vcu;u<512;u+=2*G){
    #pragma unroll 1
    for(int i=0;i<2;++i){ const int uu=u+i,g=uu>>7,b=g>>1,kvh=g&1,hq=(uu>>5)&3,qb=uu&31,h=4*kvh+hq;
      const int q0=qb*QB; const int kf=(q0-128<0)?0:q0-128, kl=(q0+QB+128>SEQ)?SEQ:q0+QB+128;
      attn_unit<THRL,1>(b,q0,kf,(kl-kf)/KVBLK,64*h,1024+64*kvh,1280+64*kvh,64*h,sink[h]*1.4426950408889634f,QKVp,O,lds); }
  }
}
#undef SBAR
#undef WAIT_BAR
}
#define GAS __attribute__((address_space(1)))
#define LAS __attribute__((address_space(3)))
typedef unsigned short bf16;
typedef unsigned v4u __attribute__((ext_vector_type(4)));
typedef float f32x4 __attribute__((ext_vector_type(4)));
typedef short bf16x8 __attribute__((ext_vector_type(8)));
typedef GAS unsigned gu32;
typedef GAS unsigned long long gu64;
#define RLX_AGENT __ATOMIC_RELAXED, __HIP_MEMORY_SCOPE_AGENT
#define LDS_WAIT() asm volatile("s_waitcnt lgkmcnt(0)" ::: "memory")
#define VM_WAIT() asm volatile("s_waitcnt vmcnt(0)" ::: "memory")
__device__ __forceinline__ unsigned long long rt() { return __builtin_amdgcn_s_memrealtime(); }
__device__ __forceinline__ unsigned f2bf(float f) { unsigned u = __builtin_bit_cast(unsigned, f); return (u + 0x7fffu + ((u >> 16) & 1u)) >> 16; }
__device__ __forceinline__ unsigned pk2(float lo, float hi) { return f2bf(lo) | (f2bf(hi) << 16); }

#define XB_TMO      128
#define XB_XCNT(j)  (256  + 64 * (j))
#define XB_XSUB(j)  (1280 + 64 * (j))
#define XB_XGEN(j)  (2304 + 64 * (j))
#define XB_TOP      3328
#define XB_TOPGEN   3392
#define XCD_BAR_WORDS 3456
#define XB_SPIN_CAP (1u << 18)

__device__ __forceinline__ unsigned xb_ld(unsigned* p)              { return __hip_atomic_load(p, __ATOMIC_RELAXED, __HIP_MEMORY_SCOPE_AGENT); }
__device__ __forceinline__ unsigned xb_add(unsigned* p, unsigned v) { return __hip_atomic_fetch_add(p, v, __ATOMIC_RELAXED, __HIP_MEMORY_SCOPE_AGENT); }
__device__ __forceinline__ unsigned xb_xcc_id() { return (unsigned)__builtin_amdgcn_s_getreg((3 << 11) | 20) & 0xFu; }
#define XB_SPIN(cond, bar) do { unsigned _sp = 0; while (cond) { __builtin_amdgcn_s_sleep(1); \
    if ((++_sp & 255u) == 0u) { if (xb_ld(&(bar)[XB_TMO])) break; if (_sp > XB_SPIN_CAP) { atomicAdd(&(bar)[XB_TMO], 1u); break; } } } } while (0)

struct XcdBarrier {
    unsigned* bar; unsigned x;
    volatile LAS unsigned* st;
};

__device__ __forceinline__ XcdBarrier xcd_barrier_post(unsigned* bar, volatile LAS unsigned* st) {
    XcdBarrier b; b.bar = bar; b.x = xb_xcc_id(); b.st = st;
    if (threadIdx.x == 0) (void)xb_add(&bar[XB_XCNT(b.x)], 1u);
    return b;
}
__device__ __forceinline__ void xcd_barrier_complete(unsigned* bar, unsigned x, unsigned& nloc, unsigned& nx) {
    const unsigned G = gridDim.x * gridDim.y * gridDim.z;
    unsigned sum, cnt, mine, sp = 0u;
    for (;;) {
        sum = 0u; cnt = 0u; mine = 0u;
#pragma unroll
        for (unsigned j = 0; j < 16; ++j) { const unsigned c = xb_ld(&bar[XB_XCNT(j)]); sum += c; cnt += (c > 0u) ? 1u : 0u; mine = (j == x) ? c : mine; }
        if (sum == G) break;
        __builtin_amdgcn_s_sleep(1);
        if ((++sp & 255u) == 0u) { if (xb_ld(&bar[XB_TMO])) break; if (sp > XB_SPIN_CAP) { atomicAdd(&bar[XB_TMO], 1u); break; } }
    }
    nloc = mine > 0u ? mine : 1u; nx = cnt > 0u ? cnt : 1u;
}

__device__ __forceinline__ void xcd_barrier(const XcdBarrier& b) {
    asm volatile("s_waitcnt vmcnt(0)" ::: "memory");
    __syncthreads();
    if (threadIdx.x == 0) {
        unsigned* bar = b.bar;
        __builtin_amdgcn_s_waitcnt(0);
        unsigned nloc = b.st[0], nx = b.st[1];
        if (nloc == 0u) { xcd_barrier_complete(bar, b.x, nloc, nx); b.st[0] = nloc; b.st[1] = nx; }
        const unsigned old = xb_add(&bar[XB_XSUB(b.x)], 1u);
        const unsigned gen = old / nloc;
        if (old + 1u == (gen + 1u) * nloc) {
            __builtin_amdgcn_fence(__ATOMIC_RELEASE, "agent");
            asm volatile("s_waitcnt vmcnt(0)" ::: "memory");
            const unsigned og = xb_add(&bar[XB_TOP], 1u);
            const unsigned tg = og / nx;
            if (og + 1u == (tg + 1u) * nx) xb_add(&bar[XB_TOPGEN], 1u);
            else XB_SPIN(xb_ld(&bar[XB_TOPGEN]) == tg, bar);
            __builtin_amdgcn_fence(__ATOMIC_ACQUIRE, "agent");
            xb_add(&bar[XB_XGEN(b.x)], 1u);
            asm volatile("s_waitcnt vmcnt(0)" ::: "memory");
        } else {
            XB_SPIN(xb_ld(&bar[XB_XGEN(b.x)]) == gen, bar);
            __builtin_amdgcn_fence(__ATOMIC_ACQUIRE, "agent");
            asm volatile("s_waitcnt vmcnt(0)" ::: "memory");
        }
    }
    __syncthreads();
}

constexpr int NWAVES = 8, NTHREADS = NWAVES * 64;
constexpr int SEQ = 8192, DM = 1024, M = 2 * SEQ;
constexpr int AB_IN = 1536, DFF = 3584, C_IN = 4128, NEXP = 8;
constexpr float EPS = 1e-6f;
constexpr float QSCALE = 0.125f * 1.4426950408889634f;
constexpr int XRP = 2048;
constexpr int MOE_MAXROWS = 135 * 256;

constexpr size_t MiB = 1u << 20;
constexpr size_t WS_CTL = 0, CTL_ZERO_BYTES = 256 * 1024;
constexpr size_t WS_SMALL = 1 * MiB;
constexpr size_t SM_GAINS = WS_SMALL, SM_WG = WS_SMALL + 4096, SM_WR = WS_SMALL + 256 * 1024, SM_HIST = WS_SMALL + 512 * 1024, SM_META = WS_SMALL + 640 * 1024;
constexpr size_t WS_TAB = 2 * MiB;
constexpr size_t WS_W_ABIN = 6 * MiB, WS_W_ABOUT = 9 * MiB, WS_W_FGU = 11 * MiB, WS_W_FD = 25 * MiB, WS_W_CIN = 32 * MiB, WS_W_COUT = 40 * MiB;
constexpr size_t WS_XN = 42 * MiB;
constexpr size_t WS_GATES = 74 * MiB;
constexpr size_t WS_SSP1 = 78 * MiB, WS_SSP2 = 79 * MiB;
constexpr size_t WS_GF = 76 * MiB, WS_GB = WS_GF + 512 * 1024, WS_BF = WS_GB + 512 * 1024, WS_BB = WS_BF + 512 * 1024;
constexpr size_t WS_QKV = 80 * MiB, WS_O = 128 * MiB, WS_ACT = 160 * MiB;
constexpr size_t WS_PROJ = 80 * MiB  , WS_Z = 176 * MiB, WS_CQ = 208 * MiB, WS_CK = 240 * MiB, WS_CV = 272 * MiB, WS_OG = 272 * MiB  ;
constexpr size_t WS_GKT = 80 * MiB, WS_GTP = 144 * MiB  , WS_GQKM = 80 * MiB  , WS_GVT = 368 * MiB, WS_GSC = 2 * MiB  , WS_OF = 304 * MiB, WS_OB = 112 * MiB;
constexpr size_t WS_XG = 2 * MiB, WS_W_MGU = WS_XG + (size_t)MOE_MAXROWS * 2048, WS_MISC2 = 230 * MiB, WS_ACTG = 235 * MiB + 512 * 1024, WS_XN2 = 240 * MiB;
constexpr size_t WS_TOPI = WS_MISC2, WS_TOPG = WS_MISC2 + 256 * 1024, WS_POS = WS_MISC2 + 512 * 1024;
constexpr size_t WS_W_MD = 181 * MiB + 512 * 1024, WS_W_MD_B = 2 * MiB, WS_Y = 58 * MiB, WS_YT = 20 * MiB; constexpr int MD_EARLY = 6;
constexpr int MOE_MAXSUB = 144;
constexpr size_t WS_END = WS_ACTG + (size_t)MOE_MAXROWS * DFF * 2;
static_assert(WS_W_MGU + (size_t)NEXP * 7168 * 1024 * 2 <= WS_MISC2 && WS_Y + (size_t)MOE_MAXROWS * 4096 <= WS_MISC2 && WS_W_MD >= WS_W_MGU + (size_t)NEXP * 7168 * 1024 * 2 && WS_W_MD + (size_t)MD_EARLY * 1024 * DFF * 2 <= WS_MISC2 && WS_W_MD_B + (size_t)(NEXP - MD_EARLY) * 1024 * DFF * 2 <= WS_YT && WS_YT + (size_t)MOE_MAXSUB * 262144 <= WS_Y, "moe map");
constexpr int CW_TMO = 0, CW_CODE = 1, CW_P10B = 2048, CW_CONV = 2112, CW_BAR = 4096;

constexpr int RING_OFF = 0, RING_BYTES = 131072, LDSCTL_OFF = RING_BYTES, MISC_OFF = LDSCTL_OFF + 320, LDS_BYTES = 163840;

__device__ __forceinline__ float bf2f(unsigned short v) { return __uint_as_float((unsigned)v << 16); }
__device__ __forceinline__ float bflo(unsigned w) { return __uint_as_float(w << 16); }
__device__ __forceinline__ float bfhi(unsigned w) { return __uint_as_float(w & 0xffff0000u); }
__device__ __forceinline__ float wave_sum(float v) {
#pragma unroll
    for (int o = 1; o < 64; o <<= 1) v += __shfl_xor(v, o);
    return v;
}

struct Frame {
    LAS unsigned char* lds; volatile LAS unsigned* MISC; gu32* ctl;
    int tid, lane, wave, vcu, G;
    unsigned char* ws; float* out;
};
struct Args { const float* in[27]; float* out; unsigned char* ws; int ph_lo, ph_hi, use_bar, pad; };

__device__ __forceinline__ int abmap(int n) {
    int tile, wc, p; bool tb = false; int d = n & 63;
    if (n < 512) { const int h = n >> 6; tile = h >> 2; wc = h & 3; }
    else if (n < 640) { tile = 4; wc = (n - 512) >> 6; }
    else if (n < 768) { tile = 5; wc = (n - 640) >> 6; }
    else if (n < 1280) { const int h = (n - 768) >> 6; tile = 2 + (h >> 2); wc = h & 3; tb = true; }
    else if (n < 1408) { tile = 4; wc = 2 + ((n - 1280) >> 6); tb = true; }
    else { tile = 5; wc = 2 + ((n - 1408) >> 6); }
    p = d; if (tb) { if (d >= 16 && d < 32) p = d + 16; else if (d >= 32 && d < 48) p = d - 16; }
    return 256 * tile + 128 * (p >> 5) + 32 * wc + (p & 31);
}
__device__ __forceinline__ int posdim_b(int p) { return (p >= 16 && p < 32) ? p + 16 : (p >= 32 && p < 48) ? p - 16 : p; }
__device__ __forceinline__ int gumap(int j, int up) { return 256 * (j >> 7) + 128 * up + (j & 127); }

template <int MODE>
__device__ __forceinline__ void transpose_item(const float* W, int K, int ldw, int nblk, bf16* WT, const float* gain, int gmask, int item, int lane) {
    const int kb = item / nblk, nb = item % nblk, kr = lane >> 4, nc = lane & 15, k0 = 64 * kb + 16 * kr, n0 = 64 * nb + 4 * nc;
    const GAS f32x4* src = (const GAS f32x4*)(W + (size_t)k0 * ldw + n0);
    f32x4 v[16];
#pragma unroll
    for (int i = 0; i < 16; ++i) v[i] = src[(size_t)i * (ldw / 4)];
    if (gain) {
        const float cs = MODE == 2 ? -1.4426950408889634f : MODE == 3 ? -0.6931471805599453f : 1.f;
#pragma unroll
        for (int q = 0; q < 4; ++q) { f32x4 g = *(const GAS f32x4*)(gain + ((k0 + 4 * q) & gmask)); if (MODE >= 2) g = g * cs;
            v[4 * q] = v[4 * q] * g.x; v[4 * q + 1] = v[4 * q + 1] * g.y; v[4 * q + 2] = v[4 * q + 2] * g.z; v[4 * q + 3] = v[4 * q + 3] * g.w; } }
#pragma unroll
    for (int j = 0; j < 4; ++j) { const int nn = n0 + j; const int row = MODE == 0 ? nn : MODE == 1 ? abmap(nn) : MODE == 2 ? gumap(nn, 0) : gumap(nn, 1);
        GAS v4u* dst = (GAS v4u*)(WT + (size_t)row * K + k0);
#pragma unroll
        for (int p = 0; p < 2; ++p) { v4u o; o.x = pg8::cvt_pk_bf16(v[8 * p][j], v[8 * p + 1][j]); o.y = pg8::cvt_pk_bf16(v[8 * p + 2][j], v[8 * p + 3][j]); o.z = pg8::cvt_pk_bf16(v[8 * p + 4][j], v[8 * p + 5][j]); o.w = pg8::cvt_pk_bf16(v[8 * p + 6][j], v[8 * p + 7][j]); dst[p] = o; } }
}
__device__ __forceinline__ float rms_row_to_bf16(int lane, const float* xrow, bf16* orow) {
    const GAS f32x4* xr = (const GAS f32x4*)xrow + lane;
    f32x4 v[4]; float s = 0.f;
#pragma unroll
    for (int j = 0; j < 4; ++j) { v[j] = xr[64 * j]; s += (v[j].x * v[j].x + v[j].y * v[j].y) + (v[j].z * v[j].z + v[j].w * v[j].w); }
    const float rstd = 1.f / sqrtf(wave_sum(s) * (1.f / DM) + EPS);
    GAS unsigned long long* o8 = (GAS unsigned long long*)orow + lane;
#pragma unroll
    for (int j = 0; j < 4; ++j) o8[64 * j] = (unsigned long long)pk2(v[j].x * rstd, v[j].y * rstd) | ((unsigned long long)pk2(v[j].z * rstd, v[j].w * rstd) << 32);
    return rstd;
}

__device__ __forceinline__ void rms_rows4(int lane, const float* x, bf16* xn, int m0, int mstride) {
    f32x4 v[4][4];
#pragma unroll
    for (int r = 0; r < 4; ++r) { const GAS f32x4* xr = (const GAS f32x4*)(x + (size_t)(m0 + r * mstride) * DM) + lane;
#pragma unroll
        for (int j = 0; j < 4; ++j) v[r][j] = xr[64 * j]; }
#pragma unroll
    for (int r = 0; r < 4; ++r) { float s = 0.f;
#pragma unroll
        for (int j = 0; j < 4; ++j) s += (v[r][j].x * v[r][j].x + v[r][j].y * v[r][j].y) + (v[r][j].z * v[r][j].z + v[r][j].w * v[r][j].w);
        const float rstd = 1.f / sqrtf(wave_sum(s) * (1.f / DM) + EPS);
        GAS unsigned long long* o8 = (GAS unsigned long long*)(xn + (size_t)(m0 + r * mstride) * DM) + lane;
#pragma unroll
        for (int j = 0; j < 4; ++j) o8[64 * j] = (unsigned long long)pg8::cvt_pk_bf16(v[r][j].x * rstd, v[r][j].y * rstd) | ((unsigned long long)pg8::cvt_pk_bf16(v[r][j].z * rstd, v[r][j].w * rstd) << 32); }
}
__device__ __forceinline__ void rms_rows4b(int lane, const bf16* xr, bf16* xn, int m0, int mstride) {
    v4u v[4][2];
#pragma unroll
    for (int r = 0; r < 4; ++r) { const GAS v4u* p = (const GAS v4u*)(xr + (size_t)(m0 + r * mstride) * XRP) + lane; v[r][0] = p[0]; v[r][1] = p[64]; }
#pragma unroll
    for (int r = 0; r < 4; ++r) { float f[16]; float s = 0.f;
#pragma unroll
        for (int q = 0; q < 2; ++q)
#pragma unroll
            for (int e = 0; e < 4; ++e) { f[8 * q + 2 * e] = bflo(v[r][q][e]); f[8 * q + 2 * e + 1] = bfhi(v[r][q][e]); }
#pragma unroll
        for (int e = 0; e < 16; ++e) s += f[e] * f[e];
        const float rstd = 1.f / sqrtf(wave_sum(s) * (1.f / DM) + EPS);
        GAS v4u* o = (GAS v4u*)(xn + (size_t)(m0 + r * mstride) * DM) + lane;
#pragma unroll
        for (int q = 0; q < 2; ++q) { v4u w;
#pragma unroll
            for (int e = 0; e < 4; ++e) w[e] = pg8::cvt_pk_bf16(f[8 * q + 2 * e] * rstd, f[8 * q + 2 * e + 1] * rstd);
            o[64 * q] = w; } }
}
__device__ __forceinline__ void p0_prologue(Frame& F, const Args& A) {
    const int gw = F.vcu * NWAVES + F.wave, NGW = F.G * NWAVES, lane = F.lane;
    unsigned char* ws = F.ws;
#define in A.in
    constexpr int I_ABIN = 16 * 24, I_ABOUT = 16 * 16;
    for (int it = gw; it < I_ABIN + I_ABOUT; it += NGW) {
        if (it < I_ABIN) transpose_item<1>(in[2], 1024, AB_IN, 24, (bf16*)(ws + WS_W_ABIN), in[1], 1023, it, lane);
        else transpose_item<0>(in[8], 1024, 1024, 16, (bf16*)(ws + WS_W_ABOUT), nullptr, 0, it - I_ABIN, lane);
    }
    const int gt = gw * 64 + lane, NGT = NGW * 64;
    float* tab1 = (float*)(ws + WS_TAB); float* tab2 = tab1 + 2 * 8192 * 32;
    for (int i = gt; i < 8192 * 32; i += NGT) { const int t = i >> 5, f = i & 31;
        { const float inv = exp2f(-13.287712379549449f * (float)(2 * f) * (1.0f / 64.0f)); const float ang = (float)t * inv;
          const double rev = (double)ang * 0.15915494309189535; const float fr = (float)(rev - __builtin_rint(rev)); tab1[i] = __builtin_amdgcn_cosf(fr); tab1[8192 * 32 + i] = __builtin_amdgcn_sinf(fr); }
        { const int ff = f & 15; const float inv = exp2f(-13.287712379549449f * (float)(2 * ff) * (1.0f / 32.0f)); const float pos = (f < 16) ? (float)(t >> 6) : (float)(t & 63); const float ang = pos * inv;
          const double rev = (double)ang * 0.15915494309189535; const float fr = (float)(rev - __builtin_rint(rev)); tab2[i] = __builtin_amdgcn_cosf(fr); tab2[8192 * 32 + i] = __builtin_amdgcn_sinf(fr); }
    }
    float* gains = (float*)(ws + SM_GAINS);
    for (int i = gt; i < 256; i += NGT) { const int sel = i >> 6, p = i & 63; float v;
        if (sel == 0) v = in[3][p]; else if (sel == 1) v = in[4][p]; else if (sel == 2) v = in[6][posdim_b(p)]; else v = in[7][posdim_b(p)];
        gains[i] = v; }
    float* wg = (float*)(ws + SM_WG);
    for (int i = gt; i < 1024 * 32; i += NGT) { const int k = i >> 5, j = i & 31; wg[((k >> 2) * 32 + j) * 4 + (k & 3)] = in[13][k] * in[14][(size_t)k * C_IN + 4096 + j]; }
    float* wrr = (float*)(ws + SM_WR);
    for (int i = gt; i < 1024 * 32; i += NGT) { const int k = i >> 5, j = i & 31; wrr[((k >> 2) * 32 + j) * 4 + (k & 3)] = j < 8 ? in[22][k] * in[23][k * 8 + j] : 0.f; }
    for (int m = gw; m + 3 * NGW < M; m += 4 * NGW) rms_rows4(lane, in[0], (bf16*)(ws + WS_XN), m, NGW);
#undef in
}
__device__ __forceinline__ void p1_deferred(Frame& F, const Args& A, int widx, int nw) {
    unsigned char* ws = F.ws; const int lane = F.lane;
    constexpr int I_G = 16 * 56, I_FD = 56 * 16, I_CIN = 16 * 64, I_COUT = 16 * 16;
    constexpr int NITEMS = 2 * I_G + I_FD + I_CIN + I_COUT;
    for (int it = widx; it < NITEMS; it += nw) {
        int r = it;
        if (r < I_G) { transpose_item<2>(A.in[10], 1024, DFF, 56, (bf16*)(ws + WS_W_FGU), A.in[9], 1023, r, lane); continue; } r -= I_G;
        if (r < I_G) { transpose_item<3>(A.in[11], 1024, DFF, 56, (bf16*)(ws + WS_W_FGU), A.in[9], 1023, r, lane); continue; } r -= I_G;
        if (r < I_FD) { transpose_item<0>(A.in[12], DFF, 1024, 16, (bf16*)(ws + WS_W_FD), nullptr, 0, r, lane); continue; } r -= I_FD;
        if (r < I_CIN) { transpose_item<0>(A.in[14], 1024, C_IN, 64, (bf16*)(ws + WS_W_CIN), A.in[13], 1023, r, lane); continue; } r -= I_CIN;
        transpose_item<0>(A.in[21], 1024, 1024, 16, (bf16*)(ws + WS_W_COUT), A.in[20], 127, r, lane);
    }
}


__device__ __forceinline__ void phase_rms(Frame& F, const bf16* xr, bf16* xn) {
    const int gw = F.vcu * NWAVES + F.wave, NGW = F.G * NWAVES;
    for (int m = gw; m + 3 * NGW < M; m += 4 * NGW) rms_rows4b(F.lane, xr, xn, m, NGW);
}
typedef float f32x16 __attribute__((ext_vector_type(16)));
__device__ __forceinline__ void gates_blocks(Frame& F, const bf16* x, const float* wg, int rb0, float* gout, LAS float* lds_out) {
    const int lane = F.lane, i = lane & 31, h = lane >> 5, w = F.wave, kq = w & 3;
    LAS float* red = (LAS float*)(F.lds + RING_OFF);
    const int rb = rb0 + (w >> 2);
    const bf16* xr = x + (size_t)(rb * 32 + i) * XRP + 256 * kq + 4 * h; const float* wp = wg + (size_t)(64 * kq) * 128 + (size_t)(h * 32 + i) * 4;
    f32x16 acc; for (int r = 0; r < 16; ++r) acc[r] = 0.f; float ss = 0.f;
#pragma unroll 8
    for (int c = 0; c < 32; ++c) {
        typedef unsigned u32x2g __attribute__((ext_vector_type(2))); const u32x2g aw = *(const GAS u32x2g*)(xr + 8 * c); const f32x4 a = (f32x4){bflo(aw.x), bfhi(aw.x), bflo(aw.y), bfhi(aw.y)}, b = *(const GAS f32x4*)(wp + (size_t)c * 256);
        ss += (a.x * a.x + a.y * a.y) + (a.z * a.z + a.w * a.w);
        acc = __builtin_amdgcn_mfma_f32_32x32x2f32(a.x, b.x, acc, 0, 0, 0); acc = __builtin_amdgcn_mfma_f32_32x32x2f32(a.y, b.y, acc, 0, 0, 0);
        acc = __builtin_amdgcn_mfma_f32_32x32x2f32(a.z, b.z, acc, 0, 0, 0); acc = __builtin_amdgcn_mfma_f32_32x32x2f32(a.w, b.w, acc, 0, 0, 0);
    }
    ss += __shfl_xor(ss, 32);
#pragma unroll
    for (int r = 0; r < 16; ++r) red[(w * 17 + r) * 64 + lane] = acc[r];
    red[(w * 17 + 16) * 64 + lane] = ss;
    __syncthreads();
    if (kq == 0) {
        float s4 = 0.f;
#pragma unroll
        for (int q = 0; q < 4; ++q) s4 += red[((w + q) * 17 + 16) * 64 + lane];
        const float rstd = 1.f / sqrtf(s4 * (1.f / DM) + EPS);
#pragma unroll
        for (int r = 0; r < 16; ++r) { float a = 0.f;
#pragma unroll
            for (int q = 0; q < 4; ++q) a += red[((w + q) * 17 + r) * 64 + lane];
            const int row = (r & 3) + 8 * (r >> 2) + 4 * h; const float rs = __shfl(rstd, row);
            if (lds_out) { if (i < 8) lds_out[((w >> 2) * 32 + row) * 8 + i] = a * rs; } else gout[(size_t)(rb * 32 + row) * 32 + i] = a * rs; }
    }
    __syncthreads();
}
__device__ __forceinline__ void phase_gates(Frame& F, const bf16* x, float* gates) {
    for (int rb0 = 2 * F.vcu; rb0 < M / 32; rb0 += 2 * F.G) gates_blocks(F, x, (const float*)(F.ws + SM_WG), rb0, gates, nullptr);
}

__device__ __forceinline__ void phase_conv(Frame& F, const Args& A, bool own_chunk) {
    const int gw = F.vcu * NWAVES + F.wave, NGW = F.G * NWAVES, lane = F.lane;
    const bf16* proj = (const bf16*)(F.ws + WS_PROJ); const float* cw = A.in[15];
    for (int it = own_chunk ? F.wave : gw; it < (own_chunk ? 24 : 1024 * 6); it += (own_chunk ? NWAVES : NGW)) {
        const int run = own_chunk ? F.vcu * 4 + it / 6 : it / 6, sh = it % 6, s = sh >> 1, hh = sh & 1;
        const int cb = 1024 * s + 512 * hh + 8 * lane;
        const bf16* projs = proj + (size_t)s * M * 1024 + 512 * hh + 8 * lane;
        bf16* dst = (bf16*)(F.ws + (s == 0 ? WS_CQ : s == 1 ? WS_CK : WS_CV)) + 512 * hh + 8 * lane;
        float w[5][8];
#pragma unroll
        for (int j = 0; j < 5; ++j) { const f32x4 a = *(const f32x4*)(cw + j * 3072 + cb), b = *(const f32x4*)(cw + j * 3072 + cb + 4); w[j][0] = a.x; w[j][1] = a.y; w[j][2] = a.z; w[j][3] = a.w; w[j][4] = b.x; w[j][5] = b.y; w[j][6] = b.z; w[j][7] = b.w; }
        const int row0 = run * 16, t0 = row0 & (SEQ - 1);
        v4u raw[20];
#pragma unroll
        for (int i = 0; i < 20; ++i) { const int tt = t0 - 2 + i; if (tt < 0 || tt >= SEQ) raw[i] = (v4u){0u, 0u, 0u, 0u}; else raw[i] = *(const GAS v4u*)(projs + (size_t)(row0 - 2 + i) * 1024); }
#pragma unroll
        for (int q = 0; q < 16; ++q) {
            float y[8]; float ss = 0.f;
#pragma unroll
            for (int e = 0; e < 8; ++e) { float a = 0.f;
#pragma unroll
                for (int j = 0; j < 5; ++j) { const unsigned wd = raw[q + j][e >> 1]; a += w[j][e] * ((e & 1) ? bfhi(wd) : bflo(wd)); }
                a = a / (1.0f + __expf(-a)); y[e] = a; ss += a * a; }
            float sc = 1.f;
            if (s < 2) { ss += __shfl_xor(ss, 1); ss += __shfl_xor(ss, 2); ss += __shfl_xor(ss, 4); ss += __shfl_xor(ss, 8); sc = (1.f / sqrtf(ss + EPS)) * (s == 0 ? 0.08838834764831845f : 1.f); }
            v4u o; o.x = pk2(y[0] * sc, y[1] * sc); o.y = pk2(y[2] * sc, y[3] * sc); o.z = pk2(y[4] * sc, y[5] * sc); o.w = pk2(y[6] * sc, y[7] * sc);
            *(GAS v4u*)(dst + (size_t)(row0 + q) * 1024) = o;
        }
    }
    const float* gates = (const float*)(F.ws + WS_GATES);
    float* GFp = (float*)(F.ws + WS_GF); float* GBp = (float*)(F.ws + WS_GB); float* BFp = (float*)(F.ws + WS_BF); float* BBp = (float*)(F.ws + WS_BB);
    const int gt = own_chunk ? F.vcu * 512 + F.tid : gw * 64 + lane, NGT = own_chunk ? M * 8 : NGW * 64;
    for (int i = gt; i < M * 8; i += NGT) { const int row = i >> 3, hd = i & 7; const float* gr = gates + (size_t)row * 32;
        { const float xx = gr[hd] + A.in[17][hd]; const float sp = xx > 20.f ? xx : log1pf(__expf(xx)); GFp[i] = -__expf(A.in[16][hd]) * sp; BFp[i] = 1.f / (1.f + __expf(-gr[8 + hd])); }
        { const float xx = gr[16 + hd] + A.in[19][hd]; const float sp = xx > 20.f ? xx : log1pf(__expf(xx)); GBp[i] = -__expf(A.in[18][hd]) * sp; BBp[i] = 1.f / (1.f + __expf(-gr[24 + hd])); }
    }
}

__device__ __forceinline__ void phase_onorm(Frame& F) {
    const int gw = F.vcu * NWAVES + F.wave, NGW = F.G * NWAVES, lane = F.lane;
    const bf16* of = (const bf16*)(F.ws + WS_OF); const bf16* ob = (const bf16*)(F.ws + WS_OB); const bf16* zb = (const bf16*)(F.ws + WS_Z); bf16* og = (bf16*)(F.ws + WS_OG);
    for (int m0 = gw; m0 + 3 * NGW < M; m0 += 4 * NGW) {
        v4u ra[4][2], rb[4][2], rc[4][2];
#pragma unroll
        for (int q = 0; q < 4; ++q)
#pragma unroll
            for (int hlf = 0; hlf < 2; ++hlf) { const size_t off = (size_t)(m0 + q * NGW) * 1024 + 16 * lane + 8 * hlf; ra[q][hlf] = *(const GAS v4u*)(of + off); rb[q][hlf] = *(const GAS v4u*)(ob + off); rc[q][hlf] = *(const GAS v4u*)(zb + off); }
#pragma unroll
        for (int q = 0; q < 4; ++q) {
            float o[16], z[16]; float ss = 0.f;
#pragma unroll
            for (int hlf = 0; hlf < 2; ++hlf)
#pragma unroll
                for (int e = 0; e < 4; ++e) { const unsigned a = ra[q][hlf][e], b = rb[q][hlf][e], c = rc[q][hlf][e];
                    o[8 * hlf + 2 * e] = bflo(a) + bflo(b); o[8 * hlf + 2 * e + 1] = bfhi(a) + bfhi(b); z[8 * hlf + 2 * e] = bflo(c); z[8 * hlf + 2 * e + 1] = bfhi(c); }
#pragma unroll
            for (int e = 0; e < 16; ++e) ss += o[e] * o[e];
            ss += __shfl_xor(ss, 1); ss += __shfl_xor(ss, 2); ss += __shfl_xor(ss, 4);
            const float r = 1.f / sqrtf(ss * (1.f / 128.f) + EPS);
            unsigned w[8];
#pragma unroll
            for (int e = 0; e < 8; ++e) { const float a = o[2 * e] * r * pg8::silu_f(z[2 * e]), b = o[2 * e + 1] * r * pg8::silu_f(z[2 * e + 1]); w[e] = pg8::cvt_pk_bf16(a, b); }
            GAS v4u* dst = (GAS v4u*)(og + (size_t)(m0 + q * NGW) * 1024 + 16 * lane); dst[0] = (v4u){w[0], w[1], w[2], w[3]}; dst[1] = (v4u){w[4], w[5], w[6], w[7]};
        }
    }
}

__device__ __forceinline__ void phase_cvt_mgu(Frame& F, const Args& A) {
    const int gw = F.vcu * NWAVES + F.wave, NGW = F.G * NWAVES;
    constexpr int I_G = 16 * 56;
    for (int it = gw; it < NEXP * 2 * I_G; it += NGW) { const int e = it / (2 * I_G), r = it % (2 * I_G); bf16* dst = (bf16*)(F.ws + WS_W_MGU) + (size_t)e * 7168 * 1024;
        if (r < I_G) transpose_item<2>(A.in[24] + (size_t)e * 1024 * DFF, 1024, DFF, 56, dst, A.in[22], 1023, r, F.lane);
        else transpose_item<3>(A.in[25] + (size_t)e * 1024 * DFF, 1024, DFF, 56, dst, A.in[22], 1023, r - I_G, F.lane); }
}
__device__ __forceinline__ void cvt_md_items(Frame& F, const Args& A, int gw, int NGW, int e_lo, int e_hi) {
    constexpr int I_D = 56 * 16;
    for (int it = e_lo * I_D + gw; it < e_hi * I_D; it += NGW) { const int e = it / I_D, r = it % I_D;
        bf16* dst = e < MD_EARLY ? (bf16*)(F.ws + WS_W_MD) + (size_t)e * 1024 * DFF : (bf16*)(F.ws + WS_W_MD_B) + (size_t)(e - MD_EARLY) * 1024 * DFF;
        transpose_item<0>(A.in[26] + (size_t)e * DFF * 1024, DFF, 1024, 16, dst, nullptr, 0, r, F.lane); }
}
__device__ __forceinline__ void phase_cvt_md(Frame& F, const Args& A) {
    if (blockIdx.x == 0) { int* meta = (int*)(F.ws + SM_META); int* tidx = meta + 16;
        pg8::MoeOrder S; S.init(meta, DM, F.G, 0, DFF, true, MOE_MAXSUB);
        for (int i = F.tid; i < 136 * 4; i += NTHREADS) tidx[i] = -1;
        __syncthreads();
        if (S.P > 1) for (int t = F.tid; t < S.T; t += NTHREADS) { pg8::Unit u; S.unit_at(S.R * S.G + t, u); tidx[u.pm * 4 + u.pn] = t; }
        if (F.tid == 0) { meta[9] = S.P > 1 ? S.T : 0; meta[10] = S.P; } }
    cvt_md_items(F, A, F.vcu * NWAVES + F.wave, F.G * NWAVES, MD_EARLY, NEXP);
}
__device__ __forceinline__ void phase_route_a(Frame& F) {
    LAS float* lg = (LAS float*)(F.lds + RING_OFF + 40 * 1024);
    const bf16* x3 = (const bf16*)F.out; bf16* xn = (bf16*)(F.ws + WS_XN2);
    int* topi = (int*)(F.ws + WS_TOPI); float* topg = (float*)(F.ws + WS_TOPG); int* histg = (int*)(F.ws + SM_HIST);
    const int lane = F.lane;
    for (int tile = F.vcu; tile < M / 64; tile += F.G) {
        gates_blocks(F, x3, (const float*)(F.ws + SM_WR), 2 * tile, nullptr, lg);
        if (F.wave == 0) {
            const int m = tile * 64 + lane; float l[8];
#pragma unroll
            for (int e = 0; e < 8; ++e) l[e] = lg[lane * 8 + e];
            int e0 = 0; float v0 = l[0];
#pragma unroll
            for (int e = 1; e < 8; ++e) if (l[e] > v0) { v0 = l[e]; e0 = e; }
            int e1 = -1; float v1 = -INFINITY;
#pragma unroll
            for (int e = 0; e < 8; ++e) if (e != e0 && l[e] > v1) { v1 = l[e]; e1 = e; }
            const float ex = __expf(v1 - v0), g0 = 1.f / (1.f + ex), g1 = ex * g0;
            *(GAS unsigned long long*)(topi + 2 * m) = (unsigned long long)(unsigned)e0 | ((unsigned long long)(unsigned)e1 << 32);
            *(GAS unsigned long long*)(topg + 2 * m) = (unsigned long long)__float_as_uint(g0) | ((unsigned long long)__float_as_uint(g1) << 32);
#pragma unroll
            for (int e = 0; e < 8; ++e) { const int cnt = __popcll(__ballot(e0 == e)) + __popcll(__ballot(e1 == e)); if (lane == e) histg[tile * 8 + e] = cnt; }
        }
        __syncthreads();
    }
}
__device__ __forceinline__ void phase_route_b(Frame& F) {
    LAS int* cnt = (LAS int*)(F.lds + RING_OFF);
    LAS int* offs = cnt + 2048;
    LAS int* tpos = cnt + 2048 + 64;
    const int* histg = (const int*)(F.ws + SM_HIST); const int* topi = (const int*)(F.ws + WS_TOPI); int* pos = (int*)(F.ws + WS_POS); int* meta = (int*)(F.ws + SM_META);
    const bf16* x3 = (const bf16*)F.out; bf16* xg = (bf16*)(F.ws + WS_XG);
    for (int i = F.tid; i < 2048; i += NTHREADS) cnt[i] = histg[i];
    __syncthreads();
    if (F.tid < 8) { int run = 0; for (int t = 0; t < 256; ++t) { const int c = cnt[t * 8 + F.tid]; cnt[t * 8 + F.tid] = run; run += c; } offs[16 + F.tid] = run; }
    __syncthreads();
    if (F.tid == 0) { int o = 0; for (int e = 0; e < 8; ++e) { offs[e] = o; o += (offs[16 + e] + 255) & ~255; } offs[8] = o; }
    __syncthreads();
    if (blockIdx.x == 0 && F.tid < 9) meta[F.tid] = offs[F.tid];
    for (int tile = F.vcu; tile < M / 64; tile += F.G) {
        if (F.wave == 0) { const int m = tile * 64 + F.lane; const int e0 = topi[2 * m], e1 = topi[2 * m + 1]; int p0 = 0, p1 = 0;
#pragma unroll
            for (int e = 0; e < 8; ++e) { const unsigned long long mk = __ballot(e0 == e || e1 == e); const int rank = __popcll(mk & ((1ull << F.lane) - 1ull)); const int base = offs[e] + cnt[tile * 8 + e];
                if (e0 == e) p0 = base + rank; if (e1 == e) p1 = base + rank; }
            pos[2 * m] = p0; pos[2 * m + 1] = p1; tpos[2 * F.lane] = p0; tpos[2 * F.lane + 1] = p1; }
        __syncthreads();
        { v4u ra[8][2];
#pragma unroll
            for (int q = 0; q < 8; ++q) { const int tk = F.wave * 8 + q; const GAS v4u* src = (const GAS v4u*)(x3 + (size_t)(tile * 64 + tk) * XRP) + F.lane; ra[q][0] = src[0]; ra[q][1] = src[64]; }
#pragma unroll
            for (int q = 0; q < 8; ++q) { const int tk = F.wave * 8 + q; float f[16]; float s = 0.f;
#pragma unroll
                for (int hq = 0; hq < 2; ++hq)
#pragma unroll
                    for (int e = 0; e < 4; ++e) { f[8 * hq + 2 * e] = bflo(ra[q][hq][e]); f[8 * hq + 2 * e + 1] = bfhi(ra[q][hq][e]); }
#pragma unroll
                for (int e = 0; e < 16; ++e) s += f[e] * f[e];
                const float rstd = 1.f / sqrtf(wave_sum(s) * (1.f / DM) + EPS);
                v4u w0, w1;
#pragma unroll
                for (int e = 0; e < 4; ++e) { w0[e] = pg8::cvt_pk_bf16(f[2 * e] * rstd, f[2 * e + 1] * rstd); w1[e] = pg8::cvt_pk_bf16(f[8 + 2 * e] * rstd, f[8 + 2 * e + 1] * rstd); }
#pragma unroll
                for (int sl = 0; sl < 2; ++sl) { GAS v4u* dst = (GAS v4u*)(xg + (size_t)tpos[2 * tk + sl] * DM) + F.lane; dst[0] = w0; dst[64] = w1; } } }
        __syncthreads();
    }
    if (blockIdx.x < 8) { const int e = blockIdx.x; const int r0 = offs[e] + offs[16 + e], r1 = offs[e + 1];
        for (int r = r0 + F.wave; r < r1; r += NWAVES) { GAS v4u* dst = (GAS v4u*)(xg + (size_t)r * DM) + F.lane; dst[0] = (v4u){0u, 0u, 0u, 0u}; dst[64] = (v4u){0u, 0u, 0u, 0u}; } }
}
__device__ __forceinline__ f32x4 moe_y_tail(const float* YT, int T, int P, int tix, int pos, int lane) {
    f32x4 a = (f32x4){0.f, 0.f, 0.f, 0.f};
    for (int p = 0; p < P; ++p) a = a + *(const GAS f32x4*)(YT + ((size_t)(p * T + tix) * 256 + (pos & 255)) * 256 + 4 * lane);
    return a;
}
__device__ __forceinline__ f32x4 bf4_to_f32(unsigned lo, unsigned hi) { return (f32x4){bflo(lo), bfhi(lo), bflo(hi), bfhi(hi)}; }
__device__ __forceinline__ void phase_combine(Frame& F) {
    typedef unsigned u32x2c __attribute__((ext_vector_type(2)));
    const int gw = F.vcu * NWAVES + F.wave, NGW = F.G * NWAVES, lane = F.lane;
    const bf16* Y = (const bf16*)(F.ws + WS_Y); const float* YT = (const float*)(F.ws + WS_YT); const int* pos = (const int*)(F.ws + WS_POS); const float* topg = (const float*)(F.ws + WS_TOPG);
    const int* meta = (const int*)(F.ws + SM_META); const int* tidx = meta + 16; const int T = __builtin_amdgcn_readfirstlane(meta[9]), P = __builtin_amdgcn_readfirstlane(meta[10]);
    for (int m0 = gw; m0 + NGW < M; m0 += 2 * NGW) {
        f32x4 xo[2][4]; u32x2c ya[2][4], yb[2][4]; float g0[2], g1[2]; int pp[2][2];
#pragma unroll
        for (int q = 0; q < 2; ++q) { const int m = m0 + q * NGW; pp[q][0] = __builtin_amdgcn_readfirstlane(pos[2 * m]); pp[q][1] = __builtin_amdgcn_readfirstlane(pos[2 * m + 1]); g0[q] = topg[2 * m]; g1[q] = topg[2 * m + 1];
            const GAS u32x2c* o = (const GAS u32x2c*)((const bf16*)F.out + (size_t)m * XRP) + lane; const GAS u32x2c* y0 = (const GAS u32x2c*)(Y + (size_t)pp[q][0] * DM) + lane; const GAS u32x2c* y1 = (const GAS u32x2c*)(Y + (size_t)pp[q][1] * DM) + lane;
#pragma unroll
            for (int j = 0; j < 4; ++j) { const u32x2c xw = o[64 * j]; xo[q][j] = bf4_to_f32(xw.x, xw.y); ya[q][j] = y0[64 * j]; yb[q][j] = y1[64 * j]; } }
        asm volatile("s_waitcnt vmcnt(0)" ::: "memory");
#pragma unroll
        for (int q = 0; q < 2; ++q) { GAS f32x4* o = (GAS f32x4*)(F.out + (size_t)(m0 + q * NGW) * DM) + lane;
#pragma unroll
            for (int j = 0; j < 4; ++j) { f32x4 a = bf4_to_f32(ya[q][j].x, ya[q][j].y), b = bf4_to_f32(yb[q][j].x, yb[q][j].y);
                if (T > 0) { const int t0 = __builtin_amdgcn_readfirstlane(tidx[(pp[q][0] >> 8) * 4 + j]), t1 = __builtin_amdgcn_readfirstlane(tidx[(pp[q][1] >> 8) * 4 + j]);
                    if (t0 >= 0) a = moe_y_tail(YT, T, P, t0, pp[q][0], lane); if (t1 >= 0) b = moe_y_tail(YT, T, P, t1, pp[q][1], lane); }
                o[64 * j] = xo[q][j] + g0[q] * a + g1[q] * b; } }
    }
}

__device__ __forceinline__ void phase_attn_naive(Frame& F, const Args& A, int it_lo, int it_hi) {
    LAS float* Ks = (LAS float*)(F.lds + RING_OFF); LAS float* Vs = Ks + 64 * 64;
    const bf16* QKV = (const bf16*)(F.ws + WS_QKV); bf16* O = (bf16*)(F.ws + WS_O); const int tid = F.tid, qi = tid >> 1, dh = tid & 1;
    for (int it = it_lo + F.vcu; it < it_hi; it += F.G) {
        const int grp = it >> 9, r = it & 511, b = r >> 8, h = grp * 8 + ((r >> 5) & 7), qb = r & 31;
        const int tq = qb * 256 + qi; const size_t row = (size_t)b * SEQ + tq;
        const bool win = h < 8; const int qcol = win ? 64 * h : 512 + 64 * (h - 8); const int kvh = win ? (h >> 2) : 2 + ((h - 8) >> 2); const int kcol = 1024 + 64 * kvh, vcol = 1280 + 64 * kvh;
        float q[64], o[32];
#pragma unroll
        for (int d = 0; d < 64; ++d) q[d] = bf2f(QKV[row * 1536 + qcol + d]);
#pragma unroll
        for (int d = 0; d < 32; ++d) o[d] = 0.f;
        float mx = -INFINITY, l = 0.f;
        const int t_lo = win ? (qb * 256 - 128 < 0 ? 0 : qb * 256 - 128) : 0, t_hi = win ? (qb * 256 + 384 > SEQ ? SEQ : qb * 256 + 384) : SEQ;
        for (int kt = t_lo; kt < t_hi; kt += 64) {
            __syncthreads();
            for (int i = tid; i < 64 * 64; i += NTHREADS) { const int rr = i >> 6, d = i & 63; const size_t kr = ((size_t)b * SEQ + kt + rr) * 1536; Ks[i] = bf2f(QKV[kr + kcol + d]); Vs[i] = bf2f(QKV[kr + vcol + d]); }
            __syncthreads();
            for (int j0 = 0; j0 < 64; j0 += 8) {
                float s[8]; float cm = -INFINITY;
#pragma unroll
                for (int jj = 0; jj < 8; ++jj) { float a = 0.f;
#pragma unroll
                    for (int d = 0; d < 64; ++d) a += q[d] * Ks[(j0 + jj) * 64 + d];
                    const int rel = tq - (kt + j0 + jj); if (win && (rel > 128 || rel < -128)) a = -INFINITY; s[jj] = a; cm = fmaxf(cm, a); }
                const float mn = fmaxf(mx, cm);
                if (mn == -INFINITY) continue;
                const float f = exp2f(mx - mn); l *= f;
#pragma unroll
                for (int d = 0; d < 32; ++d) o[d] *= f;
#pragma unroll
                for (int jj = 0; jj < 8; ++jj) { const float p = exp2f(s[jj] - mn); l += p;
#pragma unroll
                    for (int d = 0; d < 32; ++d) o[d] += p * Vs[(j0 + jj) * 64 + 32 * dh + d]; }
                mx = mn;
            }
        }
        if (win) l += exp2f(A.in[5][h] * 1.4426950408889634f - mx);
        const float rl = 1.f / l;
#pragma unroll
        for (int d = 0; d < 32; d += 2) *(unsigned*)(O + row * 1024 + 64 * h + 32 * dh + d) = pk2(o[d] * rl, o[d + 1] * rl);
        __syncthreads();
    }
}
__device__ __forceinline__ void phase_gdn_naive(Frame& F, int dlo, int dhi) {
    LAS float* ks = (LAS float*)(F.lds + RING_OFF);
    LAS float* qs = ks + 256;
    LAS float* part = qs + 256;
    LAS float* part2 = part + 1024;
    const int tid = F.tid, dv = tid & 127, qt = tid >> 7;
    const bf16* CQ = (const bf16*)(F.ws + WS_CQ); const bf16* CK = (const bf16*)(F.ws + WS_CK); const bf16* CV = (const bf16*)(F.ws + WS_CV);
    for (int it = dlo * 16 + F.vcu; it < dhi * 16; it += F.G) {
        const int dir = it >> 4, b = (it >> 3) & 1, h = it & 7;
        const float* G = (const float*)(F.ws + (dir ? WS_GB : WS_GF)); const float* BETA = (const float*)(F.ws + (dir ? WS_BB : WS_BF)); bf16* OUT = (bf16*)(F.ws + (dir ? WS_OB : WS_OF));
        float S[32];
#pragma unroll
        for (int i = 0; i < 32; ++i) S[i] = 0.f;
        for (int step = 0; step < SEQ; ++step) {
            const int t = dir ? SEQ - 1 - step : step; const size_t row = (size_t)b * SEQ + t; const int pb = step & 1;
            if (tid < 128) ks[pb * 128 + tid] = bf2f(CK[row * 1024 + h * 128 + tid]); else if (tid < 256) qs[pb * 128 + tid - 128] = bf2f(CQ[row * 1024 + h * 128 + tid - 128]);
            const float v = bf2f(CV[row * 1024 + h * 128 + dv]); const float eg = __expf(G[row * 8 + h]), beta = BETA[row * 8 + h];
            __syncthreads();
            float ps = 0.f;
#pragma unroll
            for (int i = 0; i < 32; ++i) { S[i] *= eg; ps += ks[pb * 128 + 32 * qt + i] * S[i]; }
            part[(pb * 4 + qt) * 128 + dv] = ps;
            __syncthreads();
            const float delta = beta * (v - ((part[(pb * 4 + 0) * 128 + dv] + part[(pb * 4 + 1) * 128 + dv]) + (part[(pb * 4 + 2) * 128 + dv] + part[(pb * 4 + 3) * 128 + dv])));
            float po = 0.f;
#pragma unroll
            for (int i = 0; i < 32; ++i) { S[i] += ks[pb * 128 + 32 * qt + i] * delta; po += qs[pb * 128 + 32 * qt + i] * S[i]; }
            part2[(pb * 4 + qt) * 128 + dv] = po;
            __syncthreads();
            if (qt == 0) OUT[row * 1024 + h * 128 + dv] = (bf16)f2bf((part2[(pb * 4 + 0) * 128 + dv] + part2[(pb * 4 + 1) * 128 + dv]) + (part2[(pb * 4 + 2) * 128 + dv] + part2[(pb * 4 + 3) * 128 + dv]));
        }
        __syncthreads();
    }
}

__global__ void __launch_bounds__(256) naive_attn(const bf16* __restrict__ QKV, const float* __restrict__ sink, bf16* __restrict__ O) {
    __shared__ float Ks[64][64]; __shared__ float Vs[64][64];
    const int b = blockIdx.z, h = blockIdx.y, qb = blockIdx.x, tid = threadIdx.x;
    const int tq = qb * 256 + tid; const size_t row = (size_t)b * SEQ + tq;
    const bool win = h < 8; const int qcol = win ? 64 * h : 512 + 64 * (h - 8); const int kvh = win ? (h >> 2) : 2 + ((h - 8) >> 2); const int kcol = 1024 + 64 * kvh, vcol = 1280 + 64 * kvh;
    float q[64], o[64];
#pragma unroll
    for (int d = 0; d < 64; ++d) { q[d] = bf2f(QKV[row * 1536 + qcol + d]); o[d] = 0.f; }
    float mx = -INFINITY, l = 0.f;
    const int t_lo = win ? (qb * 256 - 128 < 0 ? 0 : qb * 256 - 128) : 0, t_hi = win ? (qb * 256 + 384 > SEQ ? SEQ : qb * 256 + 384) : SEQ;
    for (int kt = t_lo; kt < t_hi; kt += 64) {
        __syncthreads();
        for (int i = tid; i < 64 * 64; i += 256) { const int r = i >> 6, d = i & 63; const size_t kr = ((size_t)b * SEQ + kt + r) * 1536; Ks[r][d] = bf2f(QKV[kr + kcol + d]); Vs[r][d] = bf2f(QKV[kr + vcol + d]); }
        __syncthreads();
        for (int j0 = 0; j0 < 64; j0 += 16) {
            float s[16]; float cm = -INFINITY;
#pragma unroll
            for (int jj = 0; jj < 16; ++jj) { float a = 0.f;
#pragma unroll
                for (int d = 0; d < 64; ++d) a += q[d] * Ks[j0 + jj][d];
                const int tk = kt + j0 + jj; const int rel = tq - tk; if (win && (rel > 128 || rel < -128)) a = -INFINITY; s[jj] = a; cm = fmaxf(cm, a); }
            const float mn = fmaxf(mx, cm);
            if (mn == -INFINITY) continue;
            const float f = exp2f(mx - mn); l *= f;
#pragma unroll
            for (int d = 0; d < 64; ++d) o[d] *= f;
#pragma unroll
            for (int jj = 0; jj < 16; ++jj) { const float p = exp2f(s[jj] - mn); l += p;
#pragma unroll
                for (int d = 0; d < 64; ++d) o[d] += p * Vs[j0 + jj][d]; }
            mx = mn;
        }
    }
    if (win) l += exp2f(sink[h] * 1.4426950408889634f - mx);
    const float rl = 1.f / l;
#pragma unroll
    for (int d = 0; d < 64; ++d) O[row * 1024 + 64 * h + d] = (bf16)f2bf(o[d] * rl);
}
__global__ void __launch_bounds__(256) naive_gdn(const bf16* __restrict__ CQ, const bf16* __restrict__ CK, const bf16* __restrict__ CV, const float* __restrict__ G, const float* __restrict__ BETA, bf16* __restrict__ OUT, int dir) {
    __shared__ float ks[2][128], qs[2][128], part[2][2][128], part2[2][2][128];
    const int b = blockIdx.x >> 3, h = blockIdx.x & 7, tid = threadIdx.x, dv = tid & 127, half = tid >> 7;
    float S[64];
#pragma unroll
    for (int i = 0; i < 64; ++i) S[i] = 0.f;
    for (int step = 0; step < SEQ; ++step) {
        const int t = dir ? SEQ - 1 - step : step; const size_t row = (size_t)b * SEQ + t; const int pb = step & 1;
        if (tid < 128) ks[pb][tid] = bf2f(CK[row * 1024 + h * 128 + tid]); else qs[pb][tid - 128] = bf2f(CQ[row * 1024 + h * 128 + tid - 128]);
        const float v = bf2f(CV[row * 1024 + h * 128 + dv]); const float eg = __expf(G[row * 8 + h]), beta = BETA[row * 8 + h];
        __syncthreads();
        float ps = 0.f;
#pragma unroll
        for (int i = 0; i < 64; ++i) { S[i] *= eg; ps += ks[pb][64 * half + i] * S[i]; }
        part[pb][half][dv] = ps;
        __syncthreads();
        const float delta = beta * (v - (part[pb][0][dv] + part[pb][1][dv]));
        float po = 0.f;
#pragma unroll
        for (int i = 0; i < 64; ++i) { S[i] += ks[pb][64 * half + i] * delta; po += qs[pb][64 * half + i] * S[i]; }
        part2[pb][half][dv] = po;
        __syncthreads();
        if (half == 0) OUT[row * 1024 + h * 128 + dv] = (bf16)f2bf(part2[pb][0][dv] + part2[pb][1][dv]);
    }
}


__device__ __forceinline__ int pi32(int m) { return (m & ~31) | (((m >> 2) & 1) << 4) | (((m >> 3) & 3) << 2) | (m & 3); }
__device__ __forceinline__ int pi32inv(int j) { return (j & ~31) | (((j >> 2) & 3) << 3) | (((j >> 4) & 1) << 2) | (j & 3); }
constexpr int mrow_off(int i) { return i == 0 ? 0 : 4 * ((((i - 1) >> 2) + 1) * (2 * ((i - 1) >> 2) + ((i - 1) & 3))); }
__device__ __forceinline__ int mrow_off_rt(int i) { const int T = i - 1, q = T >> 2, rem = T & 3; return i == 0 ? 0 : 4 * ((q + 1) * (2 * q + rem)); }
typedef float f32x16v __attribute__((ext_vector_type(16)));
constexpr int GDN_WLDS = 17408;
constexpr size_t GDN_SC_STRIDE = 192;

template <int I> struct InvRow {
    static __device__ __forceinline__ void run(float (&t)[64], const LAS float* Mp, int c) {
        InvRow<I - 1>::run(t, Mp, c);
        asm volatile("" ::: "memory");
        float a0 = (I == c) ? 1.f : 0.f, a1 = 0.f;
        const LAS f32x4* row = (const LAS f32x4*)(Mp + mrow_off(I));
#pragma unroll
        for (int jb = 0; jb < (I + 3) / 4; ++jb) { const f32x4 m = row[jb];
            if (4 * jb + 0 < I) a0 -= m.x * t[4 * jb + 0]; if (4 * jb + 1 < I) a1 -= m.y * t[4 * jb + 1]; if (4 * jb + 2 < I) a0 -= m.z * t[4 * jb + 2]; if (4 * jb + 3 < I) a1 -= m.w * t[4 * jb + 3]; }
        t[I] = a0 + a1;
    }
};
template <> struct InvRow<0> { static __device__ __forceinline__ void run(float (&t)[64], const LAS float*, int c) { t[0] = (c == 0) ? 1.f : 0.f; } };
template <int I> struct InvRowB {
    static __device__ __forceinline__ const LAS f32x4* rowp(const LAS float* Mp, int blk) { return (const LAS f32x4*)(Mp + (mrow_off(I) + ((-blk) & (mrow_off(32 + I) + 32 - mrow_off(I))))); }
    static __device__ __forceinline__ void run(float (&t)[32], const LAS float* Mp, int blk, int c, const f32x4 (&cur)[8]) {
        f32x4 nxt[8];
        if constexpr (I + 1 < 32) { const LAS f32x4* row = InvRowB<I + 1>::rowp(Mp, blk);
#pragma unroll
            for (int jb = 0; jb < (I + 1 + 3) / 4; ++jb) nxt[jb] = row[jb]; }
        asm volatile("" ::: "memory");
        float a0 = (I == c) ? 1.f : 0.f, a1 = 0.f;
#pragma unroll
        for (int jb = 0; jb < (I + 3) / 4; ++jb) { const f32x4 m = cur[jb];
            if (4 * jb + 0 < I) a0 -= m.x * t[4 * jb + 0]; if (4 * jb + 1 < I) a1 -= m.y * t[4 * jb + 1]; if (4 * jb + 2 < I) a0 -= m.z * t[4 * jb + 2]; if (4 * jb + 3 < I) a1 -= m.w * t[4 * jb + 3]; }
        t[I] = a0 + a1;
        if constexpr (I + 1 < 32) InvRowB<I + 1>::run(t, Mp, blk, c, nxt);
    }
};

__device__ __forceinline__ void phase_gdn_pre(Frame& F, int dir_lo, int dir_hi, int gw, int NGW, int n_lo, int n_hi, int single_item = -1, unsigned* war = nullptr) {
    const int ncnt = n_hi - n_lo, jend = single_item >= 0 ? 1 : (dir_hi - dir_lo) * 16 * ncnt; if (single_item >= 0) gw = 0;
    const bf16* CQ = (const bf16*)(F.ws + WS_CQ); const bf16* CK = (const bf16*)(F.ws + WS_CK); const bf16* CV = (const bf16*)(F.ws + WS_CV);
    for (int j = gw; j < jend; j += NGW) { const int item = single_item >= 0 ? single_item : (dir_lo * 16 + j / ncnt) * 128 + n_lo + j % ncnt;
        int lane = F.lane; asm volatile("" : "+v"(lane));
        LAS unsigned char* W = F.lds + (F.wave < 7 ? RING_OFF + F.wave * GDN_WLDS : 132 * 1024);
        LAS float* Mp = (LAS float*)W; LAS float* tgc = (LAS float*)(W + 8448); LAS float* tbe = tgc + 64;
        const int r32 = lane & 31, hh = lane >> 5;
        const int dir = item >> 11, b = (item >> 10) & 1, h = (item >> 7) & 7, n = item & 127;
        const int tbase = b * SEQ + (dir ? SEQ - 1 - 64 * n : 64 * n), tsgn = dir ? -1 : 1;
        const size_t grow = (size_t)(tbase + tsgn * lane) * 8 + h;
        const float g = ((const float*)(F.ws + (dir ? WS_GB : WS_GF)))[grow], be = ((const float*)(F.ws + (dir ? WS_BB : WS_BF)))[grow];
        float gc = g;
#pragma unroll
        for (int o = 1; o < 64; o <<= 1) { const float t = __shfl_up(gc, o); if (lane >= o) gc += t; }
        const float glast = __shfl(gc, 63);
        tgc[lane] = gc; tbe[lane] = be;
        float* sc = (float*)(F.ws + WS_GSC) + (size_t)item * GDN_SC_STRIDE;
        sc[lane] = __expf(gc); sc[64 + lane] = __expf(glast - gc); if (lane == 0) sc[128] = __expf(glast);
        asm volatile("" ::: "memory");
        const float gcj0 = tgc[r32], gcj1 = tgc[32 + r32];
        {
            f32x16v g00, g10, g11, s00, s10, s11;
#pragma unroll
            for (int r = 0; r < 16; ++r) { g00[r] = 0.f; g10[r] = 0.f; g11[r] = 0.f; s00[r] = 0.f; s10[r] = 0.f; s11[r] = 0.f; }
            {
                bf16x8 Kf[2][8];
#pragma unroll
                for (int I = 0; I < 2; ++I)
#pragma unroll
                    for (int ks = 0; ks < 8; ++ks) Kf[I][ks] = *(const GAS bf16x8*)(CK + (size_t)(tbase + tsgn * (32 * I + r32)) * 1024 + h * 128 + 16 * ks + 8 * hh);
                bf16x8 Qf[2][8];
#pragma unroll
                for (int I = 0; I < 2; ++I)
#pragma unroll
                    for (int ks = 0; ks < 8; ++ks) Qf[I][ks] = *(const GAS bf16x8*)(CQ + (size_t)(tbase + tsgn * (32 * I + r32)) * 1024 + h * 128 + 16 * ks + 8 * hh);
#pragma unroll
                for (int ks = 0; ks < 8; ++ks) { s00 = __builtin_amdgcn_mfma_f32_32x32x16_bf16(Qf[0][ks], Kf[0][ks], s00, 0, 0, 0); s10 = __builtin_amdgcn_mfma_f32_32x32x16_bf16(Qf[1][ks], Kf[0][ks], s10, 0, 0, 0);
                    s11 = __builtin_amdgcn_mfma_f32_32x32x16_bf16(Qf[1][ks], Kf[1][ks], s11, 0, 0, 0); }
#pragma unroll
                for (int ks = 0; ks < 8; ++ks) { g00 = __builtin_amdgcn_mfma_f32_32x32x16_bf16(Kf[0][ks], Kf[0][ks], g00, 0, 0, 0); g10 = __builtin_amdgcn_mfma_f32_32x32x16_bf16(Kf[1][ks], Kf[0][ks], g10, 0, 0, 0);
                    g11 = __builtin_amdgcn_mfma_f32_32x32x16_bf16(Kf[1][ks], Kf[1][ks], g11, 0, 0, 0); }
            }
            float gi0[16], gi1[16], bi0[16], bi1[16];
            { const LAS float* tg = tgc + 4 * hh; const LAS float* tb = tbe + 4 * hh;
#pragma unroll
                for (int r = 0; r < 16; ++r) { const int il0 = (r & 3) + 8 * (r >> 2); gi0[r] = tg[il0]; gi1[r] = tg[32 + il0]; bi0[r] = tb[il0]; bi1[r] = tb[32 + il0]; } }
            LAS bf16* img = (LAS bf16*)(W + 9216);
            const int m0 = pi32inv(r32), m1 = pi32inv(32 + r32);
            const int hhm = -hh;
            LAS float* Mr = Mp + r32; LAS bf16* im0 = img + hh * 256 + m0; LAS bf16* im1 = img + hh * 256 + m1;
#pragma unroll
            for (int r = 0; r < 16; ++r) { const int il0 = (r & 3) + 8 * (r >> 2);
                const int off0 = mrow_off(il0) + (hhm & (mrow_off(il0 + 4) - mrow_off(il0))), off1 = mrow_off(32 + il0) + (hhm & (mrow_off(36 + il0) - mrow_off(32 + il0)));
                const bool low = r32 < il0 + 4 * hh, lowe = r32 <= il0 + 4 * hh;
                const float d0 = __expf(gi0[r] - gcj0), d1 = __expf(gi1[r] - gcj0), d2 = __expf(gi1[r] - gcj1);
                if (low) Mr[off0] = bi0[r] * g00[r] * d0;
                Mr[off1] = bi1[r] * g10[r] * d1;
                if (low) Mr[off1 + 32] = bi1[r] * g11[r] * d2;
                im0[il0 * 64] = (bf16)f2bf(lowe ? s00[r] * d0 : 0.f); im1[il0 * 64] = (bf16)0;
                im0[(32 + il0) * 64] = (bf16)f2bf(s10[r] * d1); im1[(32 + il0) * 64] = (bf16)f2bf(lowe ? s11[r] * d2 : 0.f); }
            asm volatile("s_waitcnt lgkmcnt(0)" ::: "memory");
            if (war) { if (lane == 0) { unsigned sp_ = 0; while (xb_ld(war) < (unsigned)F.G && ++sp_ < (1u << 22)) __builtin_amdgcn_s_sleep(2); } asm volatile("" ::: "memory"); }
            GAS v4u* qkm = (GAS v4u*)((bf16*)(F.ws + WS_GQKM) + (size_t)item * 4096) + lane;
#pragma unroll
            for (int q = 0; q < 8; ++q) qkm[64 * q] = *(const LAS v4u*)(W + 9216 + (lane + 64 * q) * 16);
        }
        asm volatile("s_waitcnt lgkmcnt(0)" ::: "memory");
        asm volatile("" ::: "memory");
        const int blk = lane >> 5, cc = lane & 31;
        float t[32];
        { f32x4 r0[8]; InvRowB<0>::run(t, Mp, blk, cc, r0); }
        f32x16v Q2;
        {
            LAS float* T11s = (LAS float*)(W + 9216);
            asm volatile("s_waitcnt lgkmcnt(0)" ::: "memory");
            if (blk) {
#pragma unroll
                for (int i = 0; i < 32; ++i) T11s[i * 36 + cc] = t[i]; }
            const LAS f32x4* m10 = (const LAS f32x4*)(Mp + mrow_off_rt(32 + cc) + 16 * blk);
            f32x4 a4[4];
#pragma unroll
            for (int q = 0; q < 4; ++q) a4[q] = m10[q];
            f32x16v P;
#pragma unroll
            for (int r = 0; r < 16; ++r) { P[r] = 0.f; Q2[r] = 0.f; }
#pragma unroll
            for (int s_ = 0; s_ < 16; ++s_) { const float up = __shfl(t[16 + s_], cc); const float bv = blk ? up : t[s_];
                P = __builtin_amdgcn_mfma_f32_32x32x2f32(a4[s_ >> 2][s_ & 3], bv, P, 0, 0, 0); }
            asm volatile("" ::: "memory");
            const LAS f32x4* t11r = (const LAS f32x4*)(T11s + cc * 36 + 4 * blk);
            f32x4 b4[4];
#pragma unroll
            for (int q = 0; q < 4; ++q) b4[q] = t11r[2 * q];
#pragma unroll
            for (int s_ = 0; s_ < 16; ++s_) Q2 = __builtin_amdgcn_mfma_f32_32x32x2f32(b4[s_ >> 2][s_ & 3], P[s_], Q2, 0, 0, 0);
            asm volatile("s_waitcnt lgkmcnt(0)" ::: "memory");
        }
        asm volatile("" ::: "memory");
        { LAS bf16* img = (LAS bf16*)(W + 9216);
            const int pc = pi32inv(lane);
#pragma unroll
            for (int i = 0; i < 32; ++i) img[(32 * blk + i) * 64 + pc] = (bf16)f2bf(t[i] * be);
            const float bec = tbe[cc]; const int pcc = pi32inv(cc);
#pragma unroll
            for (int r = 0; r < 16; ++r) { const int il = (r & 3) + 8 * (r >> 2) + 4 * blk; img[(32 + il) * 64 + pcc] = (bf16)f2bf(-Q2[r] * bec); }
#pragma unroll
            for (int q = 0; q < 2; ++q) { const int p_ = lane + 64 * q; *(LAS v4u*)(W + 9216 + (p_ >> 2) * 128 + 64 + (p_ & 3) * 16) = (v4u){0u, 0u, 0u, 0u}; }
            asm volatile("s_waitcnt lgkmcnt(0)" ::: "memory");
            if (war) { if (lane == 0) { unsigned sp_ = 0; while (xb_ld(war) < (unsigned)F.G && ++sp_ < (1u << 22)) __builtin_amdgcn_s_sleep(2); } asm volatile("" ::: "memory"); }
            GAS v4u* tp = (GAS v4u*)((bf16*)(F.ws + WS_GTP) + (size_t)item * 4096) + lane;
#pragma unroll
            for (int q = 0; q < 8; ++q) tp[64 * q] = *(const LAS v4u*)(W + 9216 + (lane + 64 * q) * 16); }
        asm volatile("s_waitcnt lgkmcnt(0)" ::: "memory");
    }
}

typedef float f32x4v __attribute__((ext_vector_type(4)));
typedef short s16x4t __attribute__((ext_vector_type(4))); typedef short v4i16t __attribute__((ext_vector_type(4)));
__device__ __forceinline__ bf16x8 pack_tiles(const f32x4v& a, const f32x4v& b) {
    v4u p; p.x = pg8::cvt_pk_bf16(a[0], a[1]); p.y = pg8::cvt_pk_bf16(a[2], a[3]); p.z = pg8::cvt_pk_bf16(b[0], b[1]); p.w = pg8::cvt_pk_bf16(b[2], b[3]); return __builtin_bit_cast(bf16x8, p); }
constexpr int GDN_XOFF = 132 * 1024, GDN_XBUF = 5120;
constexpr int GDN_EXOFF = 142 * 1024;
constexpr int GDN_FLAGOFF = GDN_EXOFF + 12288;
constexpr int GDN_WARM = 5;
#ifndef GDN_OUT_SLEEP
#define GDN_OUT_SLEEP 4
#endif
constexpr int GDN_NSPLIT = 64;
constexpr int GDN_OSTOFF = 155 * 1024;
__device__ __forceinline__ void phase_gdn_scan(Frame& F, int dir_lo, int dir_hi) {
    if (F.vcu >= 128) return;
    const int lane = F.lane, wave = F.wave, seq = F.vcu >> 2, qtr = F.vcu & 3;
    const int dir = seq >> 4, b = (seq >> 3) & 1, h = seq & 7;
    if (dir < dir_lo || dir >= dir_hi) return;
    const int item0 = seq * 128;
    LAS unsigned char* L = F.lds + RING_OFF; LAS unsigned char* LX = F.lds + GDN_XOFF;
    const bf16* CQ = (const bf16*)(F.ws + WS_CQ); const bf16* CK = (const bf16*)(F.ws + WS_CK); const bf16* CVg = (const bf16*)(F.ws + WS_CV);
    const bf16* TPg = (const bf16*)(F.ws + WS_GTP); const bf16* QKMg = (const bf16*)(F.ws + WS_GQKM);
    const float* SC = (const float*)(F.ws + WS_GSC); bf16* OUT = (bf16*)(F.ws + (dir ? WS_OB : WS_OF));
    const int tsgn = dir ? -1 : 1;
    const int role = wave < 2 ? 0 : (wave < 4 ? 1 : 2);
    const int pr = wave & 1;
    const int c = lane & 15, qd = lane >> 4, dv0 = 32 * qtr + 16 * pr;
    unsigned long long sp[14]; int npc = 0;
    if (role == 2) {
#pragma unroll
        for (int e = 0; e < 14; ++e) { const int d = (wave - 4) + 4 * e; sp[e] = 0ull;
            if (d < 53) { npc = e + 1; const int tb_ = b * SEQ + (dir ? SEQ - 1 : 0); const char* src_;
                if (d < 32) { const int row = 4 * (d & 15) + (lane >> 4), chunk = (lane & 15) ^ (row & 15); src_ = (const char*)((d < 16 ? CK : CQ) + (size_t)(tb_ + tsgn * row) * 1024 + h * 128 + 8 * chunk); }
                else if (d < 48) { const int dd = d < 40 ? d - 32 : d - 40; const int R = 4 * dd + (lane >> 4), c16 = (lane & 15) ^ (R & 15), row = 2 * R + (c16 >> 3), ch = c16 & 7;
                    const bf16* mb = (d < 40 ? TPg : QKMg) + (size_t)item0 * 4096; src_ = (const char*)(mb + row * 64 + ch * 8); }
                else if (d < 52) { const int row = 16 * (d - 48) + (lane >> 2); src_ = (const char*)(CVg + (size_t)(tb_ + tsgn * row) * 1024 + h * 128 + 32 * qtr + 8 * (lane & 3)); }
                else src_ = (const char*)(SC + (size_t)item0 * GDN_SC_STRIDE) + lane * 16;
                sp[e] = (unsigned long long)(uintptr_t)src_; } }
    }
    const unsigned ldsbase = (unsigned)(uintptr_t)F.lds;
#define GDN_STAGE(buf_) do { unsigned wb_ = ldsbase + (unsigned)(wave - 4) * 1024u; asm volatile("" : "+s"(wb_)); long long skq_ = (long long)tsgn * 131072; asm volatile("" : "+s"(skq_)); \
        _Pragma("unroll") for (int e = 0; e < 14; ++e) if (e < 13 || wave == 4) { \
              \
            const unsigned dst_ = wb_ + (e < 12 ? (unsigned)(RING_OFF + 4 * e * 1024 + (buf_) * 65536) : (unsigned)(GDN_XOFF + (4 * e - 48) * 1024 + (buf_) * GDN_XBUF)); \
            asm volatile("s_mov_b32 m0, %1\n\ts_nop 0\n\tglobal_load_lds_dwordx4 %0, off" : : "v"(sp[e]), "s"(dst_) : "memory", "m0"); \
            sp[e] += (unsigned long long)((e < 8 || e == 12) ? skq_ : (e < 12 ? 8192ll : (long long)(GDN_SC_STRIDE * 4))); } } while (0)
    LAS unsigned char* exS = F.lds + GDN_EXOFF + pr * 6144; LAS unsigned char* exV = exS + 4096;
    LAS unsigned char* exS1 = F.lds + RING_OFF + 49152 + pr * 4096;
    volatile LAS int* fV = (volatile LAS int*)(F.lds + GDN_FLAGOFF + pr * 64); volatile LAS int* fS = fV + 8;
    if (F.tid < 64) ((LAS int*)(F.lds + GDN_FLAGOFF))[F.tid] = 0;
    f32x4v S[8];
#pragma unroll
    for (int i = 0; i < 8; ++i) S[i] = (f32x4v){0.f, 0.f, 0.f, 0.f};
    bf16x8 Sb[4];
#pragma unroll
    for (int ks = 0; ks < 4; ++ks) Sb[ks] = (bf16x8){0, 0, 0, 0, 0, 0, 0, 0};
    if (role == 0) {
#pragma unroll
        for (int ks = 0; ks < 4; ++ks) *(LAS bf16x8*)(exS + ks * 1024 + lane * 16) = Sb[ks]; }
    if (role == 2) GDN_STAGE(0);
    asm volatile("s_waitcnt vmcnt(0) lgkmcnt(0)" ::: "memory"); __builtin_amdgcn_s_barrier(); asm volatile("" ::: "memory");
    int o256[4], o128[2][2];
#pragma unroll
    for (int ks = 0; ks < 4; ++ks) o256[ks] = c * 256 + (((4 * ks + qd) ^ c) << 4);
#pragma unroll
    for (int mp = 0; mp < 2; ++mp)
#pragma unroll
        for (int ks = 0; ks < 2; ++ks) o128[mp][ks] = (c >> 1) * 256 + (((((c & 1) << 3) + 4 * ks + qd) ^ ((8 * mp + (c >> 1)) & 15)) << 4);
    const int osc = 4096 + 16 * qd;
    const int tq = (lane >> 2) & 3, tp = lane & 3, rr = 4 * qd + tq;
    const int ovt = rr * 64 + 32 * pr + 8 * tp;
    int otr[8];
#pragma unroll
    for (int dt = 0; dt < 8; ++dt) otr[dt] = rr * 256 + ((((4 * (dt >> 1) + tp) ^ rr) & 15) << 4) + ((dt & 1) << 3);
#define FRAG256(reg_, mt_, ks_) (*(const LAS bf16x8*)(Lb + o256[ks_] + ((reg_) + 4096 * (mt_))))
#define FRAG128(reg_, mt_, ks_) (*(const LAS bf16x8*)(Lb + o128[(mt_) & 1][ks_] + ((reg_) + 2048 * (mt_))))
#define MF16(a_, b_, c_) __builtin_amdgcn_mfma_f32_16x16x32_bf16((a_), (b_), (c_), 0, 0, 0)
#if defined(GDN_EXP_STAGE)
    for (int n = 0; n < 128; ++n) {
        if (role == 2) {
            { int hw_ = wave - 4; asm volatile("" : "+s"(hw_)); _Pragma("unroll") for (int e = 0; e < 14; ++e) if (e < npc) { const int d_ = hw_ + 4 * e;
                const unsigned dst_ = ldsbase + (d_ < 48 ? (unsigned)(RING_OFF + d_ * 1024 + 65536) : (unsigned)(GDN_XOFF + (d_ - 48) * 1024 + GDN_XBUF));
                const int st_ = d_ < 32 ? tsgn * 131072 : (d_ < 48 ? 8192 : (d_ < 52 ? tsgn * 131072 : (int)(GDN_SC_STRIDE * 4))); unsigned keep_;
                asm volatile("s_mov_b32 %0, m0\n\ts_mov_b32 m0, %2\n\ts_nop 0\n\tglobal_load_lds_dwordx4 %1, off\n\ts_mov_b32 m0, %0" : "=&s"(keep_) : "v"(sp[e]), "s"(dst_) : "memory");
                sp[e] += (unsigned long long)(long long)((n & 1) ? -st_ : st_); } }
            asm volatile("s_waitcnt vmcnt(0)" ::: "memory");
        }
        asm volatile("s_waitcnt lgkmcnt(0)" ::: "memory"); __builtin_amdgcn_s_barrier(); asm volatile("" ::: "memory");
    }
#endif
    for (int n = 0; n < 128; ++n) {
        const LAS unsigned char* Lb = L + (n & 1) * 65536; const LAS unsigned char* Xp = LX + (n & 1) * GDN_XBUF;
        if (role == 2) {
#ifdef GDN_STAGE_SLEEP
            __builtin_amdgcn_s_sleep(GDN_STAGE_SLEEP);
#endif
            if (n + 1 < 128) GDN_STAGE((n + 1) & 1);
            const int mw = n + GDN_WARM;
            if (false && wave == 4 && mw < 128) { const int item_ = item0 + mw; const int tb_ = b * SEQ + (dir ? SEQ - 1 - 64 * mw : 64 * mw); const char *p0, *p1;
                if (qtr == 0) { p0 = (const char*)(CK + (size_t)(tb_ + tsgn * lane) * 1024 + h * 128); p1 = p0 + 128; }
                else if (qtr == 1) { p0 = (const char*)(CQ + (size_t)(tb_ + tsgn * lane) * 1024 + h * 128); p1 = p0 + 128; }
                else if (qtr == 2) { p0 = (const char*)(TPg + (size_t)item_ * 4096) + lane * 128; p1 = p0; }
                else { p0 = (const char*)(TPg + (size_t)item_ * 4096) + lane * 128; p1 = (const char*)(QKMg + (size_t)item_ * 4096) + lane * 128; }
                const char* p2 = (const char*)(SC + (size_t)item_ * GDN_SC_STRIDE) + (lane & 7) * 128;
                LAS unsigned* dmy = (LAS unsigned*)(F.lds + GDN_FLAGOFF + 256);
                __builtin_amdgcn_global_load_lds((const unsigned*)p0, dmy, 4, 0, 0); __builtin_amdgcn_global_load_lds((const unsigned*)p1, dmy, 4, 0, 0); __builtin_amdgcn_global_load_lds((const unsigned*)p2, dmy, 4, 0, 0);
                asm volatile("s_waitcnt vmcnt(3)" ::: "memory");
            } else {
                if (n + 2 == GDN_NSPLIT && wave == 7 && F.G > 128) { if (lane == 0) { unsigned* cw = (unsigned*)(F.ctl + CW_P10B); const unsigned need = (unsigned)(F.G - 128); unsigned sp_ = 0;
                        while (xb_ld(cw) < need && ++sp_ < (1u << 24)) __builtin_amdgcn_s_sleep(2); }
                    __builtin_amdgcn_fence(__ATOMIC_ACQUIRE, "agent"); }
                asm volatile("s_waitcnt vmcnt(0)" ::: "memory"); }
        } else if (role == 0) {
            __builtin_amdgcn_s_setprio(2);
#ifdef GDN_CHAIN_SLEEP
            __builtin_amdgcn_s_sleep(GDN_CHAIN_SLEEP);
#endif
            bf16x8 Kfr[4][4];
#pragma unroll
            for (int mt = 0; mt < 4; ++mt)
#pragma unroll
                for (int ks = 0; ks < 4; ++ks) Kfr[mt][ks] = FRAG256(0, mt, ks);
            bf16x8 TPf[4][2];
#pragma unroll
            for (int mt = 0; mt < 4; ++mt)
#pragma unroll
                for (int ks = 0; ks < 2; ++ks) TPf[mt][ks] = FRAG128(32768, mt, ks);
            bf16x8 KTf[8][2];
#pragma unroll
            for (int dt = 0; dt < 8; ++dt)
#pragma unroll
                for (int ks = 0; ks < 2; ++ks) { const s16x4t lo = __builtin_bit_cast(s16x4t, __builtin_amdgcn_ds_read_tr16_b64_v4i16((LAS v4i16t*)(Lb + otr[dt] + 256 * (32 * ks)))), hi = __builtin_bit_cast(s16x4t, __builtin_amdgcn_ds_read_tr16_b64_v4i16((LAS v4i16t*)(Lb + otr[dt] + 256 * (32 * ks + 16))));
                    KTf[dt][ks] = (bf16x8){lo[0], lo[1], lo[2], lo[3], hi[0], hi[1], hi[2], hi[3]}; }
            unsigned long long vt[4]; f32x4v eg[4], ek[4];
#pragma unroll
            for (int mt = 0; mt < 4; ++mt) { vt[mt] = __builtin_bit_cast(unsigned long long, __builtin_amdgcn_ds_read_tr16_b64_v4i16((LAS v4i16t*)(Xp + ovt + 1024 * mt))); eg[mt] = *(const LAS f32x4v*)(Xp + osc + 64 * mt); ek[mt] = *(const LAS f32x4v*)(Xp + osc + 256 + 64 * mt); }
            const float gam = *(const LAS float*)(Xp + 4096 + 512);
            f32x4v X[4];
#pragma unroll
            for (int mt = 0; mt < 4; ++mt) { f32x4v a = (f32x4v){0.f, 0.f, 0.f, 0.f};
#pragma unroll
                for (int ks = 0; ks < 4; ++ks) a = MF16(Kfr[mt][ks], Sb[ks], a);
                const unsigned lo = (unsigned)vt[mt], hi = (unsigned)(vt[mt] >> 32);
                X[mt] = (f32x4v){bflo(lo), bfhi(lo), bflo(hi), bfhi(hi)} - eg[mt] * a; }
            bf16x8 Xb[2]; Xb[0] = pack_tiles(X[0], X[1]); Xb[1] = pack_tiles(X[2], X[3]);
            f32x4v VN[4];
#pragma unroll
            for (int mt = 0; mt < 4; ++mt) { f32x4v a = (f32x4v){0.f, 0.f, 0.f, 0.f};
#pragma unroll
                for (int ks = 0; ks < 2; ++ks) a = MF16(TPf[mt][ks], Xb[ks], a);
                VN[mt] = a; }
            bf16x8 VNb[2], VSb[2]; VNb[0] = pack_tiles(VN[0], VN[1]); VNb[1] = pack_tiles(VN[2], VN[3]);
            *(LAS bf16x8*)(exV + lane * 16) = VNb[0]; *(LAS bf16x8*)(exV + 1024 + lane * 16) = VNb[1];
            asm volatile("" ::: "memory");
            if (lane == 0) *fV = n + 1;
            { const f32x4v s0 = VN[0] * ek[0], s1 = VN[1] * ek[1], s2 = VN[2] * ek[2], s3 = VN[3] * ek[3]; VSb[0] = pack_tiles(s0, s1); VSb[1] = pack_tiles(s2, s3); }
#pragma unroll
            for (int dt = 0; dt < 8; ++dt) { f32x4v a = S[dt] * gam;
#pragma unroll
                for (int ks = 0; ks < 2; ++ks) a = MF16(KTf[dt][ks], VSb[ks], a);
                S[dt] = a; }
#pragma unroll
            for (int ks = 0; ks < 4; ++ks) Sb[ks] = pack_tiles(S[2 * ks], S[2 * ks + 1]);
#pragma unroll
            for (int ks = 0; ks < 4; ++ks) *(LAS bf16x8*)(((n + 1) & 1 ? exS1 : exS) + ks * 1024 + lane * 16) = Sb[ks];
        } else {
            __builtin_amdgcn_s_setprio(1);
            bf16x8 So[4];
#pragma unroll
            for (int ks = 0; ks < 4; ++ks) So[ks] = *(const LAS bf16x8*)((n & 1 ? exS1 : exS) + ks * 1024 + lane * 16);
            float egr[4];
#pragma unroll
            for (int mt = 0; mt < 4; ++mt) egr[mt] = *(const LAS float*)(Xp + 4096 + (16 * mt + c) * 4);
            bf16x8 Qfr[4][4];
#pragma unroll
            for (int mt = 0; mt < 4; ++mt)
#pragma unroll
                for (int ks = 0; ks < 4; ++ks) Qfr[mt][ks] = FRAG256(16384, mt, ks);
            asm volatile("s_waitcnt lgkmcnt(0)" ::: "memory");
            f32x4v O[4];
#pragma unroll
            for (int mt = 0; mt < 4; ++mt) { f32x4v a = (f32x4v){0.f, 0.f, 0.f, 0.f};
#pragma unroll
                for (int ks = 0; ks < 4; ++ks) a = MF16(So[ks], Qfr[mt][ks], a);
                O[mt] = a * egr[mt]; }
            bf16x8 QKf[4][2];
#pragma unroll
            for (int mt = 0; mt < 4; ++mt)
#pragma unroll
                for (int ks = 0; ks < 2; ++ks) QKf[mt][ks] = FRAG128(40960, mt, ks);
            asm volatile("" ::: "memory"); { int guard = 0; while (*fV < n + 1 && ++guard < (1 << 22)) { } } asm volatile("s_waitcnt lgkmcnt(0)" ::: "memory");
            const bf16x8 V0 = *(const LAS bf16x8*)(exV + lane * 16), V1 = *(const LAS bf16x8*)(exV + 1024 + lane * 16);
            const int tb = b * SEQ + (dir ? SEQ - 1 - 64 * n : 64 * n);
            typedef unsigned u32x2s __attribute__((ext_vector_type(2)));
#pragma unroll
            for (int mt = 0; mt < 4; ++mt) { f32x4v a = MF16(V0, QKf[mt][0], O[mt]); a = MF16(V1, QKf[mt][1], a);
                u32x2s w; w.x = pg8::cvt_pk_bf16(a[0], a[1]); w.y = pg8::cvt_pk_bf16(a[2], a[3]);
                *(GAS u32x2s*)(OUT + (size_t)(tb + tsgn * (16 * mt + c)) * 1024 + h * 128 + dv0 + 4 * qd) = w; }
        }
        asm volatile("s_waitcnt lgkmcnt(0)" ::: "memory"); __builtin_amdgcn_s_barrier(); asm volatile("" ::: "memory");
    }
    __builtin_amdgcn_s_setprio(0);
    asm volatile("s_waitcnt vmcnt(0)" ::: "memory");
#undef GDN_STAGE
#undef FRAG256
#undef FRAG128
#undef MF16
}

constexpr int NPHASE = 19;
#ifndef PROBE_MASK
#define PROBE_MASK 0u
#endif
#ifndef GDN_DLO
#define GDN_DLO 0
#define GDN_DHI 2
#endif
#ifndef ATT_SEL
#define ATT_SEL 3
#endif
__global__ void __launch_bounds__(NTHREADS, 2) mega(Args args) {
    extern __shared__ __attribute__((aligned(16))) unsigned char lds[];
    Frame F;
    F.lds = (LAS unsigned char*)lds; F.MISC = (volatile LAS unsigned*)(F.lds + MISC_OFF);
    F.tid = threadIdx.x; F.lane = F.tid & 63; F.wave = __builtin_amdgcn_readfirstlane(F.tid >> 6);
    F.G = gridDim.x; { const int bx = blockIdx.x; F.vcu = (F.G % 8 == 0) ? (bx % 8) * (F.G / 8) + bx / 8 : bx; }
    F.ws = args.ws; F.out = args.out; F.ctl = (gu32*)(args.ws + WS_CTL);
    for (int u = F.tid; u < (LDS_BYTES - LDSCTL_OFF) / 4; u += NTHREADS) ((LAS unsigned*)(F.lds + LDSCTL_OFF))[u] = 0u;
    __syncthreads();
    XcdBarrier bar; bar.bar = (unsigned*)(F.ctl + CW_BAR); bar.x = 0; bar.st = nullptr;
    if (args.use_bar) bar = xcd_barrier_post((unsigned*)(F.ctl + CW_BAR), F.MISC + 8);
    const int lo = args.ph_lo, hi = args.ph_hi;
#define IN(k) (lo <= (k) && (k) < hi)
#define PB GAS unsigned char* wsg_ = (GAS unsigned char*)args.ws; GAS float* outg_ = (GAS float*)args.out; asm volatile("" : "+s"(wsg_), "+s"(outg_)); unsigned char* ws = (unsigned char*)wsg_; float* outp = (float*)outg_; F.ws = ws; F.out = outp;     { int t_ = threadIdx.x; asm volatile("" : "+v"(t_)); F.tid = t_; F.lane = t_ & 63; F.wave = __builtin_amdgcn_readfirstlane(t_ >> 6); }
#define REP(k) for (int rp_ = 0; rp_ < (((PROBE_MASK >> (k)) & 1) ? 2 : 1); ++rp_)
#define REPBAR(k) if (((PROBE_MASK >> (k)) & 1) && rp_ == 0) xcd_barrier(bar);
#define SEAM(k) do { if (IN(k) && IN((k) + 1)) xcd_barrier(bar); } while (0)
    if (IN(0)) REP(0) { PB p0_prologue(F, args); REPBAR(0) } SEAM(0);
    if (IN(1)) REP(1) { PB pg8::Gemm g{(const bf16*)(ws + WS_XN), (const bf16*)(ws + WS_W_ABIN), M, AB_IN, DM, 0}; pg8::StaticOrder S; S.init(M, AB_IN, F.G, (int)blockIdx.x, DM);
        const float* tab1 = (const float*)(ws + WS_TAB);
        pg8::EpiQKV E{(bf16*)(ws + WS_QKV), (const float*)(ws + SM_GAINS), tab1, QSCALE, EPS};
        pg8::gemm_phase<pg8::EpiQKV, pg8::StaticOrder, PG8_ALIGN, PG8_SP2>(F.lds + RING_OFF, g, S, E);
        { const int nu2 = 384 - F.G;     if ((int)blockIdx.x >= nu2 && nu2 >= 0 && nu2 < F.G) p1_deferred(F, args, ((int)blockIdx.x - nu2) * NWAVES + F.wave, (F.G - nu2) * NWAVES); else if (nu2 < 0 || nu2 >= F.G) p1_deferred(F, args, (int)blockIdx.x * NWAVES + F.wave, F.G * NWAVES); }
        REPBAR(1) } SEAM(1);
    if (IN(2)) REP(2) { PB attn_body::attn_phase<8>((char*)lds + RING_OFF, (const attn_body::bf16*)(ws + WS_QKV), (attn_body::bf16*)(ws + WS_O), args.in[5], F.vcu, F.G, ATT_SEL); if (ATT_SEL != 3) { __syncthreads(); phase_attn_naive(F, args, (ATT_SEL & 2) ? 512 : 0, (ATT_SEL & 1) ? 512 : 1024); } REPBAR(2) } SEAM(2);
    if (IN(3)) REP(3) { PB pg8::Gemm g{(const bf16*)(ws + WS_O), (const bf16*)(ws + WS_W_ABOUT), M, DM, DM, 0}; pg8::StaticOrder S; S.init(M, DM, F.G, (int)blockIdx.x, DM);
        pg8::EpiResBf16T<true> E{args.in[0], DM, nullptr, (bf16*)outp, XRP};
        pg8::gemm_phase<pg8::EpiResBf16T<true>, pg8::StaticOrder, PG8_ALIGN, PG8_SP2>(F.lds + RING_OFF, g, S, E); REPBAR(3) } SEAM(3);
    if (IN(4)) REP(4) { PB phase_rms(F, (const bf16*)outp, (bf16*)(ws + WS_XN)); REPBAR(4) } SEAM(4);
    if (IN(5)) REP(5) { PB pg8::Gemm g{(const bf16*)(ws + WS_XN), (const bf16*)(ws + WS_W_FGU), M, 2 * DFF, DM, 0}; pg8::StaticOrder S; S.init(M, 2 * DFF, F.G, (int)blockIdx.x, DM);
        pg8::EpiSwiGLU E{(bf16*)(ws + WS_ACT), DFF, nullptr, EPS};
        pg8::gemm_phase<pg8::EpiSwiGLU, pg8::StaticOrder, PG8_ALIGN, PG8_SP2>(F.lds + RING_OFF, g, S, E); REPBAR(5) } SEAM(5);
    if (IN(6)) REP(6) { PB pg8::Gemm g{(const bf16*)(ws + WS_ACT), (const bf16*)(ws + WS_W_FD), M, DM, DFF, 0}; pg8::StaticOrder S; S.init(M, DM, F.G, (int)blockIdx.x, DFF);
        pg8::EpiResBf16T<false> E{nullptr, 0, (const bf16*)outp, (bf16*)outp, XRP};
        pg8::gemm_phase<pg8::EpiResBf16T<false>, pg8::StaticOrder, PG8_ALIGN, PG8_SP2>(F.lds + RING_OFF, g, S, E); REPBAR(6) } SEAM(6);
    if (IN(7)) REP(7) { PB phase_rms(F, (const bf16*)outp, (bf16*)(ws + WS_XN)); phase_gates(F, (const bf16*)outp, (float*)(ws + WS_GATES)); REPBAR(7) } SEAM(7);
    if (IN(8)) REP(8) { PB pg8::Gemm g{(const bf16*)(ws + WS_XN), (const bf16*)(ws + WS_W_CIN), M, 3072, DM, 0}; pg8::StaticOrder S; S.init(M, 3072, F.G, (int)blockIdx.x, DM);
        pg8::EpiBf16<0> E{(bf16*)(ws + WS_PROJ), 1024, nullptr, 1024, (size_t)M * 1024, 1.f};
        pg8::gemm_phase<pg8::EpiBf16<0>, pg8::StaticOrder, PG8_ALIGN, PG8_SP2>(F.lds + RING_OFF, g, S, E); REPBAR(8) } SEAM(8);
    const bool p9_fused = (F.G == 256) && IN(9) && IN(10);
    if (IN(9)) REP(9) { PB phase_conv(F, args, p9_fused);
        if (p9_fused) { asm volatile("s_waitcnt vmcnt(0)" ::: "memory"); __syncthreads();
            if (F.tid == 0) (void)xb_add((unsigned*)(F.ctl + CW_CONV), 1u);
            const int b_ = F.vcu >> 7, c_ = F.vcu & 127, dir_ = c_ >> 6, n_ = dir_ ? 127 - c_ : c_;
            phase_gdn_pre(F, 0, 2, 0, 1, 0, GDN_NSPLIT, ((dir_ * 2 + b_) * 8 + F.wave) * 128 + n_, (unsigned*)(F.ctl + CW_CONV)); }
        REPBAR(9) } if (!p9_fused) SEAM(9);
    if (IN(10)) REP(10) { PB if (!p9_fused) phase_gdn_pre(F, GDN_DLO, GDN_DHI, F.vcu * NWAVES + F.wave, F.G * NWAVES, 0, F.G > 128 ? GDN_NSPLIT : 128); REPBAR(10) } SEAM(10);
    if (IN(11)) REP(11) { PB
        if (F.vcu >= 128) {
            phase_gdn_pre(F, GDN_DLO, GDN_DHI, (F.vcu - 128) * NWAVES + F.wave, (F.G - 128) * NWAVES, GDN_NSPLIT, 128);
            asm volatile("s_waitcnt vmcnt(0)" ::: "memory"); __syncthreads();
            if (F.tid == 0) { __builtin_amdgcn_fence(__ATOMIC_RELEASE, "agent"); asm volatile("s_waitcnt vmcnt(0)" ::: "memory"); (void)xb_add((unsigned*)(F.ctl + CW_P10B), 1u); }
            __syncthreads(); }
        if (F.vcu >= 128) {
            pg8::Gemm gz{(const bf16*)(ws + WS_XN), (const bf16*)(ws + WS_W_CIN) + (size_t)3072 * 1024, M, 1024, DM, 0}; pg8::StaticOrder Sz; Sz.init(M, 1024, F.G - 128, F.vcu - 128, DM);
            pg8::EpiBf16<0> Ez{(bf16*)(ws + WS_Z), 1024, nullptr, 0, 0, 1.f};
            pg8::gemm_phase<pg8::EpiBf16<0>, pg8::StaticOrder, PG8_ALIGN, PG8_SP2>(F.lds + RING_OFF, gz, Sz, Ez); }
        phase_gdn_scan(F, GDN_DLO, GDN_DHI); if (GDN_DLO > 0 || GDN_DHI < 2) { __syncthreads(); phase_gdn_naive(F, GDN_DLO > 0 ? 0 : GDN_DHI, GDN_DLO > 0 ? GDN_DLO : 2); } REPBAR(11) } SEAM(11);
    if (IN(12)) REP(12) { PB phase_onorm(F); REPBAR(12) } SEAM(12);
    if (IN(13)) REP(13) { PB pg8::Gemm g{(const bf16*)(ws + WS_OG), (const bf16*)(ws + WS_W_COUT), M, DM, DM, 0}; pg8::StaticOrder S; S.init(M, DM, F.G, (int)blockIdx.x, DM);
        pg8::EpiResBf16T<false> E{nullptr, 0, (const bf16*)outp, (bf16*)outp, XRP};
        pg8::gemm_phase<pg8::EpiResBf16T<false>, pg8::StaticOrder, PG8_ALIGN, PG8_SP2>(F.lds + RING_OFF, g, S, E); REPBAR(13) } SEAM(13);
    if (IN(14)) REP(14) { PB phase_route_a(F); phase_cvt_mgu(F, args); REPBAR(14) } SEAM(14);
    if (IN(15)) REP(15) { PB phase_route_b(F); REPBAR(15) } SEAM(15);
    if (IN(16)) REP(16) { PB pg8::Gemm g{(const bf16*)(ws + WS_XG), (const bf16*)(ws + WS_W_MGU), MOE_MAXROWS, 2 * DFF, DM, (size_t)7168 * 1024 * 2}; pg8::MoeOrder S; S.init((const int*)(ws + SM_META), 2 * DFF, F.G, (int)blockIdx.x, DM, false, 0);
        pg8::EpiSwiGLU E{(bf16*)(ws + WS_ACTG), DFF, nullptr, EPS};
        pg8::gemm_phase<pg8::EpiSwiGLU, pg8::MoeOrder, PG8_ALIGN, PG8_SP2>(F.lds + RING_OFF, g, S, E);
        { const int T_ = S.T, c_ = (int)blockIdx.x;
          if (T_ == 0) cvt_md_items(F, args, c_ * NWAVES + F.wave, F.G * NWAVES, 0, MD_EARLY); else if (c_ >= T_) cvt_md_items(F, args, (c_ - T_) * NWAVES + F.wave, (F.G - T_) * NWAVES, 0, MD_EARLY); }
        REPBAR(16) } SEAM(16);
    if (IN(17)) REP(17) { PB phase_cvt_md(F, args); REPBAR(17) } SEAM(17);
    if (IN(18)) REP(18) { PB pg8::Gemm g{(const bf16*)(ws + WS_ACTG), (const bf16*)(ws + WS_W_MD), MOE_MAXROWS, DM, DFF, (size_t)1024 * DFF * 2, MD_EARLY, (long long)WS_W_MD_B - (long long)WS_W_MD - (long long)MD_EARLY * 1024 * DFF * 2}; pg8::MoeOrder S; S.init((const int*)(ws + SM_META), DM, F.G, (int)blockIdx.x, DFF, true, MOE_MAXSUB);
        pg8::EpiF32 E{(bf16*)(ws + WS_Y), DM, (float*)(ws + WS_YT), S.T};
        pg8::gemm_phase<pg8::EpiF32, pg8::MoeOrder, PG8_ALIGN, PG8_SP2>(F.lds + RING_OFF, g, S, E); REPBAR(18) } SEAM(18);
    if (IN(19)) { PB phase_combine(F); }
#undef IN
#undef SEAM
}

extern "C" void kernel_launch(void* const* d_in, const int* in_sizes, int n_in, void* d_out, int out_size, void* d_ws, size_t ws_size, hipStream_t stream) {
    static int grid = 0;
    if (grid == 0) {
        if (n_in != 27 || in_sizes[0] != M * DM || out_size != M * DM || ws_size < WS_END) { fprintf(stderr, "kernel_launch: unexpected problem (n_in %d, in0 %d, out %d, ws %zu < %zu); nothing launched\n", n_in, n_in > 0 ? in_sizes[0] : -1, out_size, ws_size, (size_t)WS_END); grid = -1; return; }
        int dev = 0, cus = 0, per_cu = 0;
        if (hipGetDevice(&dev) != hipSuccess || hipDeviceGetAttribute(&cus, hipDeviceAttributeMultiprocessorCount, dev) != hipSuccess) { grid = -1; return; }
        if (hipFuncSetAttribute((const void*)mega, hipFuncAttributeMaxDynamicSharedMemorySize, LDS_BYTES) != hipSuccess) { fprintf(stderr, "kernel_launch: hipFuncSetAttribute failed\n"); grid = -1; return; }
        if (hipOccupancyMaxActiveBlocksPerMultiprocessor(&per_cu, (const void*)mega, NTHREADS, LDS_BYTES) != hipSuccess || per_cu < 1) fprintf(stderr, "kernel_launch: occupancy query says %d\n", per_cu);
        (void)hipGetLastError();
        grid = cus;
    }
    if (grid < 0) return;
    (void)hipMemsetAsync((char*)d_ws + WS_CTL, 0, CTL_ZERO_BYTES, stream);
    Args a{};
    for (int i = 0; i < 27; ++i) a.in[i] = (const float*)d_in[i];
    a.out = (float*)d_out; a.ws = (unsigned char*)d_ws; a.use_bar = 1; a.pad = 0;
    a.ph_lo = 0; a.ph_hi = 20;
    hipLaunchKernelGGL(mega, dim3(grid), dim3(NTHREADS), LDS_BYTES, stream, a);
}
```

```cpp
#include <hip/hip_runtime.h>
#include <cstdio>
#include <cstdint>
#include <cmath>
namespace pg8 {
#define PG8_LAS __attribute__((address_space(3)))
typedef unsigned short bf16_t;
typedef short bf16x8 __attribute__((ext_vector_type(8)));
typedef float f32x4 __attribute__((ext_vector_type(4)));
typedef unsigned u32x4 __attribute__((ext_vector_type(4)));
constexpr int BM = 256, BK = 64, HALF = 128, HTB = HALF * BK * 2  , STAGE_BYTES = 8 * HTB, NXCD = 8, WGM = 8;

__host__ __device__ __forceinline__ int lds_byte(int r, int c) { const int st = (r >> 4) * 2 + (c >> 5), rr = r & 15, cc = c & 31, ob = rr * 64 + cc * 2; return st * 1024 + (ob ^ (((ob >> 9) & 1) << 5)); }
__host__ __device__ __forceinline__ void stage_rc(int b, int& R, int& C) { const int st = b / 1024, sb = b % 1024, swz = sb ^ (((sb >> 9) & 1) << 5); R = (st >> 1) * 16 + swz / 64; C = (st & 1) * 32 + (swz % 64) / 2; }
__host__ __device__ __forceinline__ int perm32(int rho) { const int n = rho >> 4, i = rho & 15; return 8 * (i >> 2) + 4 * n + (i & 3); }

struct Unit { int pm, pn, e, k0, nt, part, tix; };
struct Gemm { const bf16_t* A; const bf16_t* Bt; int M, N, K; size_t estride; int esplit = 1 << 30; long long edelta = 0; };

struct StaticOrder {
    int nM, nN, nwg, G, c, ntk;
    __host__ __device__ __forceinline__ void init(int M, int N, int G_, int c_, int K_) { nM = M / BM; nN = N / BM; nwg = nM * nN; G = G_; c = c_; ntk = K_ / BK; }
    __host__ __device__ __forceinline__ bool next(int i, Unit& u) const {
        const long L = (long)i * G + c; if (L >= nwg) return false;
        int wgid = (int)L; { const int q = nwg / NXCD, r = nwg % NXCD, xcd = wgid % NXCD, off = wgid / NXCD; wgid = (xcd < r ? xcd * (q + 1) : r * (q + 1) + (xcd - r) * q) + off; }
        const int nig = WGM * nN, gid = wgid / nig, fm = gid * WGM, gsz = (nM - fm) < WGM ? (nM - fm) : WGM;
        u.pm = fm + ((wgid % nig) % gsz); u.pn = (wgid % nig) / gsz; u.e = 0; u.k0 = 0; u.nt = ntk; u.part = -1; u.tix = 0; return true;
    }
    __device__ __forceinline__ void a_ready(const Unit&) const {}
    __device__ __forceinline__ void done(const Unit&) const {}
};

typedef float f32x2c __attribute__((ext_vector_type(2))); typedef __bf16 bf16x2c __attribute__((ext_vector_type(2)));
__device__ __forceinline__ unsigned cvt_pk_bf16(float lo, float hi) { const f32x2c v = {lo, hi}; const bf16x2c b = __builtin_convertvector(v, bf16x2c); return __builtin_bit_cast(unsigned, b); }
typedef float f32x2 __attribute__((ext_vector_type(2)));
__device__ __forceinline__ f32x2 gelu_pk(f32x2 v) {
    const f32x2 av = __builtin_elementwise_abs(v), d = av * 0.2316418882f + 1.0f;
    f32x2 t; t.x = __builtin_amdgcn_rcpf(d.x); t.y = __builtin_amdgcn_rcpf(d.y);
    f32x2 q = t * 0.5307027145f + (-0.7265760135f); q = q * t + 0.7107068705f; q = q * t + (-0.142248368f); q = q * t + 0.127414796f; q = q * t;
    const f32x2 s = (v * v) * (-0.72134752044f);
    f32x2 e; e.x = __builtin_amdgcn_exp2f(s.x); e.y = __builtin_amdgcn_exp2f(s.y);
    const f32x2 m = v * (q * e), r = v - m;
    f32x2 o; o.x = v.x < 0.f ? m.x : r.x; o.y = v.y < 0.f ? m.y : r.y; return o;
}

template <int ACT  > struct EpiBf16 {
    static constexpr bool PERM = true, AFTER_DRAIN = false; static_assert(ACT == 0 || ACT == 1, "EpiBf16: ACT is 0 (none) or 1 (gelu_pk)");
    bf16_t* O; int ldc; const float* bias; int split_cols; size_t split_stride; float scale0;
    __device__ __forceinline__ void operator()(const f32x4 (&acc)[2][2][4][2], const Unit& u, int wr, int wc, int fr, int fq) const {
        const int row0 = u.pm * BM + wr * 64 + fr; int colt = u.pn * BM; bf16_t* base = O;
        float sc = 1.f; if (split_cols) { const int t = colt / split_cols; base += (size_t)t * split_stride; colt -= t * split_cols; if (t == 0) sc = scale0; }
        const int col0 = colt + wc * 32 + 8 * fq, bcol0 = u.pn * BM + wc * 32 + 8 * fq;
        f32x4 bv[2][2];
#pragma unroll
        for (int bj = 0; bj < 2; ++bj)
#pragma unroll
            for (int n = 0; n < 2; ++n) bv[bj][n] = bias ? *(const f32x4*)(bias + bcol0 + bj * HALF + 4 * n) : (f32x4){0.f, 0.f, 0.f, 0.f};
#pragma unroll
        for (int ai = 0; ai < 2; ++ai)
#pragma unroll
            for (int m = 0; m < 4; ++m) { bf16_t* rowp = base + (size_t)(row0 + ai * HALF + m * 16) * ldc + col0;
#pragma unroll
                for (int bj = 0; bj < 2; ++bj) { f32x4 v0 = acc[ai][bj][m][0] + bv[bj][0], v1 = acc[ai][bj][m][1] + bv[bj][1];
                    if (ACT == 1) { f32x2 a = gelu_pk((f32x2){v0[0], v0[1]}), b = gelu_pk((f32x2){v0[2], v0[3]}), c = gelu_pk((f32x2){v1[0], v1[1]}), d = gelu_pk((f32x2){v1[2], v1[3]});
                        v0 = (f32x4){a.x, a.y, b.x, b.y}; v1 = (f32x4){c.x, c.y, d.x, d.y}; }
                    v0 = v0 * sc; v1 = v1 * sc; u32x4 w; w.x = cvt_pk_bf16(v0[0], v0[1]); w.y = cvt_pk_bf16(v0[2], v0[3]); w.z = cvt_pk_bf16(v1[0], v1[1]); w.w = cvt_pk_bf16(v1[2], v1[3]);
                    *(u32x4*)(rowp + bj * HALF) = w; } }
    }
};

__device__ __forceinline__ float swiglu_f(float g, float u) { return (g * u) * __builtin_amdgcn_rcpf(1.0f + __builtin_amdgcn_exp2f(g)); }
__device__ __forceinline__ float silu_f(float x) { return x * __builtin_amdgcn_rcpf(1.0f + __builtin_amdgcn_exp2f(-1.4426950408889634f * x)); }
__device__ __forceinline__ float row_rstd(const float* ssp, int row, float eps) {
    const f32x4* p = (const f32x4*)(ssp + (size_t)row * 16); const f32x4 a = p[0], b = p[1], c = p[2], d = p[3];
    const float s = ((a[0] + a[1]) + (a[2] + a[3])) + ((b[0] + b[1]) + (b[2] + b[3])) + (((c[0] + c[1]) + (c[2] + c[3])) + ((d[0] + d[1]) + (d[2] + d[3])));
    return 1.0f / sqrtf(s * (1.0f / 1024.0f) + eps); }
struct EpiResF32 {
    static constexpr bool PERM = false, AFTER_DRAIN = false;
    const float* base; float* out; int ldc; bf16_t* xb; float* ssp;
    __device__ __forceinline__ void operator()(const f32x4 (&acc)[2][2][4][2], const Unit& u, int wr, int wc, int fr, int fq) const {
        typedef unsigned u32x2e __attribute__((ext_vector_type(2)));
        const int col0 = u.pn * BM + wc * 32 + 4 * fq;
#pragma unroll
        for (int ai = 0; ai < 2; ++ai)
#pragma unroll
            for (int m = 0; m < 4; ++m) { const int row = u.pm * BM + ai * HALF + wr * 64 + m * 16 + fr; const size_t off = (size_t)row * ldc + col0; float ss = 0.f;
#pragma unroll
                for (int bj = 0; bj < 2; ++bj)
#pragma unroll
                    for (int n = 0; n < 2; ++n) { const f32x4 bs = *(const f32x4*)(base + off + bj * HALF + n * 16); const f32x4 o = bs + acc[ai][bj][m][n]; *(f32x4*)(out + off + bj * HALF + n * 16) = o;
                        if (xb) { u32x2e w; w.x = cvt_pk_bf16(o[0], o[1]); w.y = cvt_pk_bf16(o[2], o[3]); *(u32x2e*)(xb + off + bj * HALF + n * 16) = w; ss += (o[0] * o[0] + o[1] * o[1]) + (o[2] * o[2] + o[3] * o[3]); } }
                if (xb) { ss += __shfl_xor(ss, 16); ss += __shfl_xor(ss, 32); if (fq == 0) ssp[(size_t)row * 16 + u.pn * 4 + wc] = ss; }
                if (m & 1) asm volatile("" ::: "memory"); }
    }
};
template <bool F32BASE> struct EpiResBf16T {
    static constexpr bool PERM = true, AFTER_DRAIN = false;
    const float* basef; int ldb; const bf16_t* baseb; bf16_t* out; int ldo;
    __device__ __forceinline__ void operator()(const f32x4 (&acc)[2][2][4][2], const Unit& u, int wr, int wc, int fr, int fq) const {
        typedef __attribute__((address_space(1))) const u32x4 gu4c; typedef __attribute__((address_space(1))) const f32x4 gf4c;
        const int col0 = u.pn * BM + wc * 32 + 8 * fq, row0 = u.pm * BM + wr * 64 + fr;
        if constexpr (!F32BASE) {
            u32x4 rw[2][4][2];
#pragma unroll
            for (int ai = 0; ai < 2; ++ai)
#pragma unroll
                for (int m = 0; m < 4; ++m)
#pragma unroll
                    for (int bj = 0; bj < 2; ++bj) rw[ai][m][bj] = *(gu4c*)(baseb + (size_t)(row0 + ai * HALF + m * 16) * ldo + col0 + bj * HALF);
#pragma unroll
            for (int ai = 0; ai < 2; ++ai)
#pragma unroll
                for (int m = 0; m < 4; ++m)
#pragma unroll
                    for (int bj = 0; bj < 2; ++bj) { const u32x4 w0 = rw[ai][m][bj];
                        const f32x4 b0 = (f32x4){__uint_as_float(w0.x << 16), __uint_as_float(w0.x & 0xffff0000u), __uint_as_float(w0.y << 16), __uint_as_float(w0.y & 0xffff0000u)};
                        const f32x4 b1 = (f32x4){__uint_as_float(w0.z << 16), __uint_as_float(w0.z & 0xffff0000u), __uint_as_float(w0.w << 16), __uint_as_float(w0.w & 0xffff0000u)};
                        const f32x4 o0 = b0 + acc[ai][bj][m][0], o1 = b1 + acc[ai][bj][m][1];
                        u32x4 w; w.x = cvt_pk_bf16(o0[0], o0[1]); w.y = cvt_pk_bf16(o0[2], o0[3]); w.z = cvt_pk_bf16(o1[0], o1[1]); w.w = cvt_pk_bf16(o1[2], o1[3]);
                        *(u32x4*)(out + (size_t)(row0 + ai * HALF + m * 16) * ldo + col0 + bj * HALF) = w; }
        } else {
#pragma unroll
            for (int ai = 0; ai < 2; ++ai) { f32x4 rb[4][2][2];
#pragma unroll
                for (int m = 0; m < 4; ++m)
#pragma unroll
                    for (int bj = 0; bj < 2; ++bj) { const float* bp = basef + (size_t)(row0 + ai * HALF + m * 16) * ldb + col0 + bj * HALF; rb[m][bj][0] = *(gf4c*)bp; rb[m][bj][1] = *(gf4c*)(bp + 4); }
#pragma unroll
                for (int m = 0; m < 4; ++m)
#pragma unroll
                    for (int bj = 0; bj < 2; ++bj) { const f32x4 o0 = rb[m][bj][0] + acc[ai][bj][m][0], o1 = rb[m][bj][1] + acc[ai][bj][m][1];
                        u32x4 w; w.x = cvt_pk_bf16(o0[0], o0[1]); w.y = cvt_pk_bf16(o0[2], o0[3]); w.z = cvt_pk_bf16(o1[0], o1[1]); w.w = cvt_pk_bf16(o1[2], o1[3]);
                        *(u32x4*)(out + (size_t)(row0 + ai * HALF + m * 16) * ldo + col0 + bj * HALF) = w; }
                asm volatile("" ::: "memory"); }
        }
    }
};
struct EpiF32 {
    static constexpr bool PERM = true, AFTER_DRAIN = false;
    bf16_t* out; int ldc; float* part; int T;
    __device__ __forceinline__ void operator()(const f32x4 (&acc)[2][2][4][2], const Unit& u, int wr, int wc, int fr, int fq) const {
        const bool pt = u.part >= 0;
        char* base = pt ? (char*)(part + (size_t)(u.part * T + u.tix) * 65536 + wc * 32 + 8 * fq) : (char*)(out + (size_t)(u.pm * BM) * ldc + u.pn * BM + wc * 32 + 8 * fq);
        const size_t pitch = pt ? 1024 : (size_t)ldc * 2; int r0 = wr * 64 + fr; asm volatile("" : "+v"(r0));
#pragma unroll
        for (int ai = 0; ai < 2; ++ai)
#pragma unroll
            for (int m = 0; m < 4; ++m) { char* rowp = base + (size_t)(ai * HALF + m * 16 + r0) * pitch;
#pragma unroll
                for (int bj = 0; bj < 2; ++bj) { const f32x4 v0 = acc[ai][bj][m][0], v1 = acc[ai][bj][m][1];
                    if (pt) { *(f32x4*)(rowp + bj * HALF * 4) = v0; *(f32x4*)(rowp + bj * HALF * 4 + 16) = v1; }
                    else { u32x4 w; w.x = cvt_pk_bf16(v0[0], v0[1]); w.y = cvt_pk_bf16(v0[2], v0[3]); w.z = cvt_pk_bf16(v1[0], v1[1]); w.w = cvt_pk_bf16(v1[2], v1[3]); *(u32x4*)(rowp + bj * HALF * 2) = w; } } }
    }
};
struct EpiSwiGLU {
    static constexpr bool PERM = true, AFTER_DRAIN = false;
    bf16_t* O; int ldc; const float* ssp; float eps;
    __device__ __forceinline__ void operator()(const f32x4 (&acc)[2][2][4][2], const Unit& u, int wr, int wc, int fr, int fq) const {
        const int col0 = u.pn * HALF + wc * 32 + 8 * fq;
#pragma unroll
        for (int ai = 0; ai < 2; ++ai)
#pragma unroll
            for (int m = 0; m < 4; ++m) { const int row = u.pm * BM + ai * HALF + wr * 64 + m * 16 + fr; bf16_t* rowp = O + (size_t)row * ldc + col0;
                const float r = ssp ? row_rstd(ssp, row, eps) : 1.0f;
                const f32x4 g0 = acc[ai][0][m][0] * r, g1 = acc[ai][0][m][1] * r, u0 = acc[ai][1][m][0] * r, u1 = acc[ai][1][m][1] * r;
                u32x4 w; w.x = cvt_pk_bf16(swiglu_f(g0[0], u0[0]), swiglu_f(g0[1], u0[1])); w.y = cvt_pk_bf16(swiglu_f(g0[2], u0[2]), swiglu_f(g0[3], u0[3]));
                w.z = cvt_pk_bf16(swiglu_f(g1[0], u1[0]), swiglu_f(g1[1], u1[1])); w.w = cvt_pk_bf16(swiglu_f(g1[2], u1[2]), swiglu_f(g1[3], u1[3]));
                *(u32x4*)rowp = w; }
    }
};
struct EpiBf16Split {
    static constexpr bool PERM = true, AFTER_DRAIN = false;
    bf16_t* O; int ldc; int split_cols; size_t split_stride; const float* ssp; float eps;
    __device__ __forceinline__ void operator()(const f32x4 (&acc)[2][2][4][2], const Unit& u, int wr, int wc, int fr, int fq) const {
        int colt = u.pn * BM; const int t = colt / split_cols; bf16_t* base = O + (size_t)t * split_stride; colt -= t * split_cols;
        const int col0 = colt + wc * 32 + 8 * fq;
#pragma unroll
        for (int ai = 0; ai < 2; ++ai)
#pragma unroll
            for (int m = 0; m < 4; ++m) { const int row = u.pm * BM + ai * HALF + wr * 64 + m * 16 + fr; bf16_t* rowp = base + (size_t)row * ldc + col0; const float r = row_rstd(ssp, row, eps);
#pragma unroll
                for (int bj = 0; bj < 2; ++bj) { const f32x4 v0 = acc[ai][bj][m][0] * r, v1 = acc[ai][bj][m][1] * r; u32x4 w; w.x = cvt_pk_bf16(v0[0], v0[1]); w.y = cvt_pk_bf16(v0[2], v0[3]); w.z = cvt_pk_bf16(v1[0], v1[1]); w.w = cvt_pk_bf16(v1[2], v1[3]);
                    *(u32x4*)(rowp + bj * HALF) = w; } }
    }
};
struct EpiQKV {
    static constexpr bool PERM = true, AFTER_DRAIN = false;
    bf16_t* O; const float* gains;
    const float* tab;
    float qscale, eps;
    __device__ __forceinline__ void operator()(const f32x4 (&acc)[2][2][4][2], const Unit& u, int wr, int wc, int fr, int fq) const {
        const int tile = u.pn; int gsel = 0; bool ax = false; float sc = 1.f; bool plain = false;
        if (tile < 2) { gsel = 0; ax = false; sc = qscale; } else if (tile < 4) { gsel = 2; ax = true; sc = qscale; } else if (tile == 4) { if (wc < 2) { gsel = 1; ax = false; } else { gsel = 3; ax = true; } } else plain = true;
        bf16_t* obase = O + tile * 256 + wc * 64 + 8 * fq;
        if (plain) {
#pragma unroll
            for (int ai = 0; ai < 2; ++ai)
#pragma unroll
                for (int m = 0; m < 4; ++m) { bf16_t* rowp = obase + (size_t)(u.pm * BM + ai * HALF + wr * 64 + m * 16 + fr) * 1536;
#pragma unroll
                    for (int bj = 0; bj < 2; ++bj) { const f32x4 v0 = acc[ai][bj][m][0], v1 = acc[ai][bj][m][1]; u32x4 w; w.x = cvt_pk_bf16(v0[0], v0[1]); w.y = cvt_pk_bf16(v0[2], v0[3]); w.z = cvt_pk_bf16(v1[0], v1[1]); w.w = cvt_pk_bf16(v1[2], v1[3]);
                        *(u32x4*)(rowp + 32 * bj) = w; } }
            return;
        }
        const float* gp = gains + gsel * 64 + 8 * fq; const float* tabp = tab + (ax ? 2 * 8192 * 32 : 0);
        f32x4 ga[2][2];
#pragma unroll
        for (int bj = 0; bj < 2; ++bj)
#pragma unroll
            for (int n = 0; n < 2; ++n) ga[bj][n] = *(const f32x4*)(gp + 32 * bj + 4 * n);
#pragma unroll
        for (int ai = 0; ai < 2; ++ai)
#pragma unroll
            for (int m = 0; m < 4; ++m) {
                const int row = u.pm * BM + ai * HALF + wr * 64 + m * 16 + fr, t = row & 8191;
                f32x4 x1[2], x2[2]; x1[0] = acc[ai][0][m][0]; x1[1] = acc[ai][0][m][1]; x2[0] = acc[ai][1][m][0]; x2[1] = acc[ai][1][m][1];
                float ss = 0.f;
#pragma unroll
                for (int n = 0; n < 2; ++n)
#pragma unroll
                    for (int j = 0; j < 4; ++j) ss += x1[n][j] * x1[n][j] + x2[n][j] * x2[n][j];
                ss += __shfl_xor(ss, 16); ss += __shfl_xor(ss, 32);
                const float r = 1.0f / sqrtf(ss * (1.0f / 64.0f) + eps);
                const float* cp = tabp + (size_t)t * 32 + 8 * fq; const float* sp = cp + 8192 * 32;
                u32x4 w1, w2;
#pragma unroll
                for (int n = 0; n < 2; ++n) { const f32x4 c = *(const f32x4*)(cp + 4 * n), s = *(const f32x4*)(sp + 4 * n);
                    const f32x4 y1 = x1[n] * r * ga[0][n], y2 = x2[n] * r * ga[1][n];
                    const f32x4 o1 = (y1 * c - y2 * s) * sc, o2 = (y2 * c + y1 * s) * sc;
                    w1[2 * n] = cvt_pk_bf16(o1[0], o1[1]); w1[2 * n + 1] = cvt_pk_bf16(o1[2], o1[3]); w2[2 * n] = cvt_pk_bf16(o2[0], o2[1]); w2[2 * n + 1] = cvt_pk_bf16(o2[2], o2[3]); }
                bf16_t* rowp = obase + (size_t)row * 1536;
                *(u32x4*)rowp = w1; *(u32x4*)(rowp + 32) = w2;
            }
    }
};
__device__ __forceinline__ int moe_tail_parts(int T, int G, int maxsub) { const int lim = (G < maxsub ? G : maxsub); int P = 1;
    if (T * 2 <= lim) P = 2; if (T * 4 <= lim) P = 4; if (T * 7 <= lim) P = 7; if (T * 14 <= lim) P = 14; return T > 0 ? P : 1; }
struct MoeOrder {
    int nM, nN, nwg, G, c, ntk, R, T, P; int t0[9];
    __device__ __forceinline__ void init(const int* meta, int N, int G_, int c_, int K_, bool split, int maxsub) {
#pragma unroll
        for (int e = 0; e < 9; ++e) t0[e] = __builtin_amdgcn_readfirstlane(meta[e]) >> 8;
        nM = t0[8]; nN = N / BM; nwg = nM * nN; G = G_; c = c_; ntk = K_ / BK; R = nwg / G; T = nwg % G; P = split ? moe_tail_parts(T, G, maxsub) : 1; }
    __device__ __forceinline__ void unit_at(int L, Unit& u) const {
        int wgid = L; { const int q = nwg / NXCD, r = nwg % NXCD, xcd = wgid % NXCD, off = wgid / NXCD; wgid = (xcd < r ? xcd * (q + 1) : r * (q + 1) + (xcd - r) * q) + off; }
        const int nig = WGM * nN, gid = wgid / nig, fm = gid * WGM, gsz = (nM - fm) < WGM ? (nM - fm) : WGM;
        u.pm = fm + ((wgid % nig) % gsz); u.pn = (wgid % nig) / gsz; int e = 0;
#pragma unroll
        for (int k = 1; k < 8; ++k) e += (u.pm >= t0[k]) ? 1 : 0;
        u.e = e; u.k0 = 0; u.nt = ntk; u.part = -1; u.tix = 0; }
    __device__ __forceinline__ bool next(int i, Unit& u) const {
        if (i < R) { unit_at(i * G + c, u); return true; }
        if (i > R || c >= T * P) return false;
        const int tix = c / P, part = c % P; unit_at(R * G + tix, u);
        if (P > 1) { u.nt = ntk / P; u.k0 = part * u.nt; u.part = part; u.tix = tix; }
        return true;
    }
    __device__ __forceinline__ void a_ready(const Unit&) const {}
    __device__ __forceinline__ void done(const Unit&) const {}
};
template <class Epi, class Sched, bool ALIGN_EPI = false, bool SP2 = false>
__device__ __forceinline__ void gemm_phase(PG8_LAS unsigned char* lds, const Gemm g, const Sched& S, const Epi& E) {
    int tid = threadIdx.x; asm volatile("" : "+v"(tid));
    const int wid = __builtin_amdgcn_readfirstlane(tid >> 6), lane = tid & 63, wr = wid >> 2, wc = wid & 3, fr = lane & 15, fq = lane >> 4;
    const int K = g.K, nt = K / BK;
    unsigned voffA[2], voffB[2];
#pragma unroll
    for (int i = 0; i < 2; ++i) { int R, C; stage_rc(tid * 16 + i * 8192, R, C); const int Rb = Epi::PERM ? ((R & ~31) + perm32(R & 31)) : R;
        voffA[i] = (unsigned)(R * K + C) * 2u; voffB[i] = (unsigned)(Rb * K + C) * 2u; }
    const size_t kstep = (size_t)(BK * 2);
    const size_t hstep = (size_t)HALF * K * 2;
    const size_t tstep = 2 * hstep;
    const unsigned ldsw = (unsigned)wid * 1024u;
    const int aoff = lds_byte(wr * 64 + fr, fq * 8), boff = lds_byte(wc * 32 + fr, fq * 8);
#define PG8_SA(b, h) (((b) * 2 + (h)) * HTB)
#define PG8_SB(b, h) ((4 + (b) * 2 + (h)) * HTB)
#define PG8_STAGE(bufoff, gbase, voff) do { _Pragma("unroll") for (int _i = 0; _i < 2; ++_i) \
        __builtin_amdgcn_global_load_lds((const unsigned*)((const char*)(gbase) + (voff)[_i]), (PG8_LAS unsigned*)(lds + (bufoff) + ldsw + _i * 8192), 16, 0, 0); } while (0)
#define PG8_LDA(dst, b, h) do { _Pragma("unroll") for (int m = 0; m < 4; ++m) _Pragma("unroll") for (int k = 0; k < 2; ++k) dst[m][k] = *(const PG8_LAS bf16x8*)(lds + PG8_SA(b, h) + aoff + m * 2048 + k * 1024); } while (0)
#define PG8_LDB(dst, b, h) do { _Pragma("unroll") for (int n = 0; n < 2; ++n) _Pragma("unroll") for (int k = 0; k < 2; ++k) dst[n][k] = *(const PG8_LAS bf16x8*)(lds + PG8_SB(b, h) + boff + n * 2048 + k * 1024); } while (0)
#define PG8_MMA(ai, bj, At, Bt) do { __builtin_amdgcn_s_setprio(1); _Pragma("unroll") for (int m = 0; m < 4; ++m) _Pragma("unroll") for (int n = 0; n < 2; ++n) _Pragma("unroll") for (int k = 0; k < 2; ++k) \
        acc[ai][bj][m][n] = __builtin_amdgcn_mfma_f32_16x16x32_bf16(Bt[n][k], At[m][k], acc[ai][bj][m][n], 0, 0, 0); __builtin_amdgcn_s_setprio(0); } while (0)
#define PG8_WAIT_V(n) asm volatile("s_waitcnt vmcnt(" #n ")" ::: "memory")
#define PG8_WAIT_L(n) asm volatile("s_waitcnt lgkmcnt(" #n ")" ::: "memory")
#define PG8_BAR __builtin_amdgcn_s_barrier()
#define PG8_SCHED __builtin_amdgcn_sched_barrier(0)
    Unit cur, nxt; int ui = 0;
    if (!S.next(0, cur)) return;
    f32x4 acc[2][2][4][2];
#pragma unroll
    for (int a = 0; a < 2; ++a)
#pragma unroll
        for (int b = 0; b < 2; ++b)
#pragma unroll
            for (int m = 0; m < 4; ++m)
#pragma unroll
                for (int n = 0; n < 2; ++n) acc[a][b][m][n] = (f32x4){0.f, 0.f, 0.f, 0.f};
    bf16x8 At[4][2], B0[2][2], B1[2][2];
    const char* cA = (const char*)g.A + (size_t)cur.pm * tstep + (size_t)cur.k0 * kstep; const char* cB = (const char*)g.Bt + (size_t)cur.e * g.estride + (cur.e >= g.esplit ? g.edelta : 0ll) + (size_t)cur.pn * tstep + (size_t)cur.k0 * kstep;
    int cnt = cur.nt;
    S.a_ready(cur);
    if constexpr (SP2) {
        PG8_STAGE(PG8_SB(0, 0), cB, voffB); PG8_STAGE(PG8_SB(0, 1), cB + hstep, voffB); PG8_STAGE(PG8_SA(0, 0), cA, voffA); PG8_STAGE(PG8_SA(0, 1), cA + hstep, voffA);
        if (wr == 1) PG8_BAR;
        PG8_WAIT_V(2); PG8_BAR;
        PG8_STAGE(PG8_SB(1, 0), cB + kstep, voffB); PG8_STAGE(PG8_SA(1, 0), cA + kstep, voffA); PG8_STAGE(PG8_SB(1, 1), cB + hstep + kstep, voffB);
        PG8_WAIT_V(6); PG8_BAR;
    } else {
        PG8_STAGE(PG8_SB(0, 0), cB, voffB); PG8_STAGE(PG8_SA(0, 0), cA, voffA); PG8_STAGE(PG8_SB(0, 1), cB + hstep, voffB); PG8_STAGE(PG8_SA(0, 1), cA + hstep, voffA);
        if (wr == 1) PG8_BAR;
        PG8_WAIT_V(4); PG8_BAR;
        PG8_STAGE(PG8_SB(1, 0), cB + kstep, voffB); PG8_STAGE(PG8_SA(1, 0), cA + kstep, voffA); PG8_STAGE(PG8_SB(1, 1), cB + hstep + kstep, voffB);
        PG8_WAIT_V(6); PG8_BAR;
    }
    for (;;) {
        const bool has_next = S.next(ui + 1, nxt);
        const char* nA = has_next ? (const char*)g.A + (size_t)nxt.pm * tstep + (size_t)nxt.k0 * kstep : cA; const char* nB = has_next ? (const char*)g.Bt + (size_t)nxt.e * g.estride + (nxt.e >= g.esplit ? g.edelta : 0ll) + (size_t)nxt.pn * tstep + (size_t)nxt.k0 * kstep : cB;
        for (int t = 0; t < cnt; t += 2) {
            const bool last = (t == cnt - 2);
            const char* a1 = cA + (size_t)(t + 1) * kstep;
            const char* a2 = last ? nA : cA + (size_t)(t + 2) * kstep; const char* b2 = last ? nB : cB + (size_t)(t + 2) * kstep;
            const char* a3 = a2 + kstep; const char* b3 = b2 + kstep;
            if (last && has_next) S.a_ready(nxt);
            if constexpr (SP2) {
            PG8_LDB(B0, 0, 0); PG8_LDB(B1, 0, 1); PG8_SCHED; PG8_LDA(At, 0, 0); PG8_STAGE(PG8_SA(1, 1), a1 + hstep, voffA);
            PG8_WAIT_V(8); PG8_WAIT_L(0); PG8_BAR; PG8_MMA(0, 0, At, B0); PG8_MMA(0, 1, At, B1); PG8_BAR; PG8_SCHED;
            PG8_LDA(At, 0, 1); PG8_STAGE(PG8_SB(0, 0), b2, voffB); PG8_STAGE(PG8_SB(0, 1), b2 + hstep, voffB); PG8_STAGE(PG8_SA(0, 0), a2, voffA);
            PG8_WAIT_V(8); PG8_WAIT_L(0); PG8_BAR; PG8_MMA(1, 0, At, B0); PG8_MMA(1, 1, At, B1); PG8_BAR; PG8_SCHED;
            PG8_LDB(B0, 1, 0); PG8_LDB(B1, 1, 1); PG8_SCHED; PG8_LDA(At, 1, 0); PG8_STAGE(PG8_SA(0, 1), a2 + hstep, voffA);
            PG8_WAIT_V(8); PG8_WAIT_L(0); PG8_BAR; PG8_MMA(0, 0, At, B0); PG8_MMA(0, 1, At, B1); PG8_BAR; PG8_SCHED;
            PG8_LDA(At, 1, 1); PG8_STAGE(PG8_SB(1, 0), b3, voffB); PG8_STAGE(PG8_SB(1, 1), b3 + hstep, voffB); PG8_STAGE(PG8_SA(1, 0), a3, voffA);
            PG8_WAIT_V(8); PG8_WAIT_L(0); PG8_BAR; PG8_MMA(1, 0, At, B0); PG8_MMA(1, 1, At, B1); PG8_BAR; PG8_SCHED;
            } else {
            PG8_LDB(B0, 0, 0); PG8_SCHED; PG8_LDA(At, 0, 0); PG8_STAGE(PG8_SA(1, 1), a1 + hstep, voffA);
            PG8_WAIT_L(8); PG8_BAR; PG8_WAIT_L(0); PG8_MMA(0, 0, At, B0); PG8_BAR; PG8_SCHED;
            PG8_LDB(B1, 0, 1); PG8_STAGE(PG8_SB(0, 0), b2, voffB);
            PG8_BAR; PG8_WAIT_L(0); PG8_MMA(0, 1, At, B1); PG8_BAR;
            PG8_LDA(At, 0, 1); PG8_STAGE(PG8_SA(0, 0), a2, voffA);
            PG8_BAR; PG8_WAIT_L(0); PG8_MMA(1, 0, At, B0); PG8_BAR; PG8_SCHED;
            PG8_STAGE(PG8_SB(0, 1), b2 + hstep, voffB);
            PG8_WAIT_V(6); PG8_BAR; PG8_MMA(1, 1, At, B1); PG8_BAR;
            PG8_LDB(B0, 1, 0); PG8_SCHED; PG8_LDA(At, 1, 0); PG8_STAGE(PG8_SA(0, 1), a2 + hstep, voffA);
            PG8_WAIT_L(8); PG8_BAR; PG8_WAIT_L(0); PG8_MMA(0, 0, At, B0); PG8_BAR; PG8_SCHED;
            PG8_LDB(B1, 1, 1); PG8_STAGE(PG8_SB(1, 0), b3, voffB);
            PG8_BAR; PG8_WAIT_L(0); PG8_MMA(0, 1, At, B1); PG8_BAR;
            PG8_LDA(At, 1, 1); PG8_STAGE(PG8_SA(1, 0), a3, voffA);
            PG8_BAR; PG8_WAIT_L(0); PG8_MMA(1, 0, At, B0); PG8_BAR; PG8_SCHED;
            PG8_STAGE(PG8_SB(1, 1), b3 + hstep, voffB);
            PG8_WAIT_V(6); PG8_BAR; PG8_MMA(1, 1, At, B1); PG8_BAR;
            }
        }
        if constexpr (ALIGN_EPI) { if (wr == 0) PG8_BAR; }
        if constexpr (!Epi::AFTER_DRAIN) { E(acc, cur, wr, wc, fr, fq); S.done(cur); }
        if (!has_next) break;
#pragma unroll
        for (int a = 0; a < 2; ++a)
#pragma unroll
            for (int b = 0; b < 2; ++b)
#pragma unroll
                for (int m = 0; m < 4; ++m)
#pragma unroll
                    for (int n = 0; n < 2; ++n) acc[a][b][m][n] = (f32x4){0.f, 0.f, 0.f, 0.f};
        cur = nxt; cA = nA; cB = nB; cnt = cur.nt; ++ui;
        if constexpr (ALIGN_EPI) { if (wr == 1) PG8_BAR; }
    }
    PG8_WAIT_V(0);
    if constexpr (!ALIGN_EPI) { if (wr == 0) PG8_BAR; }
    PG8_BAR;
    if constexpr (Epi::AFTER_DRAIN) { E.fused(acc, cur, wr, wc, fr, fq, lds, wid, lane); S.done(cur); }
#undef PG8_SA
#undef PG8_SB
#undef PG8_STAGE
#undef PG8_LDA
#undef PG8_LDB
#undef PG8_MMA
#undef PG8_WAIT_V
#undef PG8_WAIT_L
#undef PG8_BAR
#undef PG8_SCHED
}
}

#ifndef PG8_SP2
#define PG8_SP2 true
#endif
#ifndef PG8_ALIGN
#define PG8_ALIGN true
#endif
#include <hip/hip_bf16.h>
#include <cmath>
namespace attn_body {
using bf16=__hip_bfloat16;
using bf16x8=__attribute__((ext_vector_type(8)))short;
using s16x4=__attribute__((ext_vector_type(4)))short;
using f32x16=__attribute__((ext_vector_type(16)))float;
using u32x4=__attribute__((ext_vector_type(4)))unsigned;
constexpr int SEQ=8192,D=64,QP=1536,OP=1024;
constexpr int NW=8,QBLK=32,QB=QBLK*NW,KVBLK=64,NQB=SEQ/QB;
constexpr int ATTN_UNIT_ROWS=QB;
__device__ __forceinline__ int crow(int r,int hi){return (r&3)+8*(r>>2)+4*hi;}
#define SBAR() __builtin_amdgcn_sched_barrier(0)
__device__ __forceinline__ void wmask(f32x16&p0,f32x16&p1,int dq,int hi){
  const float NEG=-INFINITY; const int d0=dq-4*hi;
  #pragma unroll
  for(int r=0;r<16;++r){const int rel=d0-((r&3)+8*(r>>2)); if(rel>128||rel<-128)p0[r]=NEG; if(rel-32>128||rel-32<-128)p1[r]=NEG;}
}
constexpr int NSLOT=3, SLOTB=8192;
constexpr int LDS_K=0, LDS_V=NSLOT*SLOTB, LDS_WS=2*NSLOT*SLOTB, LDS_OST=LDS_WS+NW*64*4, LDS_BYTES=LDS_OST+NW*4096;
constexpr float C2=0.125f*1.4426950408889634f;
template<int OFF> __device__ __forceinline__ void glds16(const void*sbase,unsigned voff,unsigned lds_dst){unsigned keep;
  asm volatile("s_mov_b32 %0, m0\n\ts_mov_b32 m0, %3\n\ts_nop 0\n\tglobal_load_lds_dwordx4 %1, %2 offset:%c4\n\ts_mov_b32 m0, %0":"=&s"(keep):"v"(voff),"s"(sbase),"s"(lds_dst),"i"(OFF):"memory");}
__device__ __forceinline__ float max3f(float a,float b,float c){float r;asm("v_max3_f32 %0, %1, %2, %3":"=v"(r):"v"(a),"v"(b),"v"(c));return r;}
__device__ __forceinline__ float max2f(float a,float b){float r;asm("v_max_f32_e32 %0, %1, %2":"=v"(r):"v"(a),"v"(b));return r;}
__device__ __forceinline__ float fadd_s(float a,float b){float r;asm("v_add_f32_e32 %0, %1, %2":"=v"(r):"v"(a),"v"(b));return r;}
__device__ __forceinline__ float fsub_s(float a,float b){float r;asm("v_sub_f32_e32 %0, %1, %2":"=v"(r):"v"(a),"v"(b));return r;}
typedef float f32x2_t __attribute__((ext_vector_type(2))); typedef __bf16 bf16x2_t __attribute__((ext_vector_type(2)));
__device__ __forceinline__ unsigned cvtpk_s(float lo,float hi){f32x2_t v={lo,hi};bf16x2_t b=__builtin_convertvector(v,bf16x2_t);return __builtin_bit_cast(unsigned,b);}
#define WAIT_BAR(N) asm volatile("s_waitcnt vmcnt(" #N ") lgkmcnt(0)\n\ts_barrier":::"memory")

__device__ __forceinline__ void qkt(f32x16&p0,f32x16&p1,const char*Kslot,const bf16x8*qr,const f32x16&negm,int r32,int hi){
  const char*kb=Kslot+hi*1024+r32*16;
  #pragma unroll
  for(int d0=0;d0<4;++d0){
    const bf16x8 b0=*reinterpret_cast<const bf16x8*>(kb+d0*2048);
    const bf16x8 b1=*reinterpret_cast<const bf16x8*>(kb+d0*2048+512);
    if(d0==0){p0=__builtin_amdgcn_mfma_f32_32x32x16_bf16(b0,qr[0],negm,0,0,0);p1=__builtin_amdgcn_mfma_f32_32x32x16_bf16(b1,qr[0],negm,0,0,0);}
    else{p0=__builtin_amdgcn_mfma_f32_32x32x16_bf16(b0,qr[d0],p0,0,0,0);p1=__builtin_amdgcn_mfma_f32_32x32x16_bf16(b1,qr[d0],p1,0,0,0);}}
}
typedef __attribute__((address_space(3))) const char* lds_cptr;
typedef short v4i16_t __attribute__((ext_vector_type(4)));
__device__ __forceinline__ void kload8(bf16x8*kf,lds_cptr kp){
  kf[0]=*(const __attribute__((address_space(3))) bf16x8*)(kp);      kf[1]=*(const __attribute__((address_space(3))) bf16x8*)(kp+512);
  kf[2]=*(const __attribute__((address_space(3))) bf16x8*)(kp+2048); kf[3]=*(const __attribute__((address_space(3))) bf16x8*)(kp+2560);
  kf[4]=*(const __attribute__((address_space(3))) bf16x8*)(kp+4096); kf[5]=*(const __attribute__((address_space(3))) bf16x8*)(kp+4608);
  kf[6]=*(const __attribute__((address_space(3))) bf16x8*)(kp+6144); kf[7]=*(const __attribute__((address_space(3))) bf16x8*)(kp+6656);
}
__device__ __forceinline__ void kload2(bf16x8*kf,lds_cptr kp,int j){ kf[2*j]=*(const __attribute__((address_space(3))) bf16x8*)(kp+j*2048); kf[2*j+1]=*(const __attribute__((address_space(3))) bf16x8*)(kp+j*2048+512); }
__device__ __forceinline__ s16x4 vtr(lds_cptr p){ return __builtin_bit_cast(s16x4,__builtin_amdgcn_ds_read_tr16_b64_v4i16((__attribute__((address_space(3))) v4i16_t*)p)); }
__device__ __forceinline__ float rowmax(const f32x16&p0,const f32x16&p1){
  float a=max3f(p0[0],p0[1],p1[0]),b=max3f(p0[2],p0[3],p1[1]);a=max3f(a,p1[2],p1[3]);
  #pragma unroll
  for(int r=4;r<16;r+=4){a=max3f(a,p0[r],p0[r+1]);b=max3f(b,p0[r+2],p0[r+3]);a=max3f(a,p1[r],p1[r+1]);b=max3f(b,p1[r+2],p1[r+3]);}
  const float m=max2f(a,b);
  auto rr=__builtin_amdgcn_permlane32_swap(__float_as_uint(m),__float_as_uint(m),false,false);
  return max2f(__uint_as_float(rr[0]),__uint_as_float(rr[1]));
}
__device__ __forceinline__ void pv(f32x16*o,int vb,bf16x8 pa0,bf16x8 pa1,bf16x8 pa2,bf16x8 pa3){
  #pragma unroll
  for(int d0=0;d0<2;++d0){s16x4 lo[4],hi[4];
    #pragma unroll
    for(int ks=0;ks<4;++ks){
      asm volatile("ds_read_b64_tr_b16 %0,%1 offset:%c2":"=&v"(lo[ks]):"v"(vb),"i"(d0*4096+ks*1024):"memory");
      asm volatile("ds_read_b64_tr_b16 %0,%1 offset:%c2":"=&v"(hi[ks]):"v"(vb),"i"(d0*4096+ks*1024+512):"memory");}
    asm volatile("s_waitcnt lgkmcnt(0)":::"memory");SBAR();
    #define PK(k) (bf16x8){lo[k][0],lo[k][1],lo[k][2],lo[k][3],hi[k][0],hi[k][1],hi[k][2],hi[k][3]}
    o[d0]=__builtin_amdgcn_mfma_f32_32x32x16_bf16(pa0,PK(0),o[d0],0,0,0);
    o[d0]=__builtin_amdgcn_mfma_f32_32x32x16_bf16(pa1,PK(1),o[d0],0,0,0);
    o[d0]=__builtin_amdgcn_mfma_f32_32x32x16_bf16(pa2,PK(2),o[d0],0,0,0);
    o[d0]=__builtin_amdgcn_mfma_f32_32x32x16_bf16(pa3,PK(3),o[d0],0,0,0);
    #undef PK
  }
}

#ifndef ATTN_STORE16
#define ATTN_STORE16(p,v) (*(u32x4*)(p)=(v))
#endif
template<int THRL,int MODE> __device__ __forceinline__ void attn_unit(int b,int q0,int kfirst,int NT,int qcol,int kcol,int vcol,int ocol,float sink2,const bf16*QKVp,bf16*O,char*shm){
  int tid=threadIdx.x; asm volatile("":"+v"(tid)); const int lane=tid&63,r32=lane&31,hi=lane>>5; const int wid=__builtin_amdgcn_readfirstlane(tid>>6);
  const long rowbase=(long)b*SEQ;
  const bf16*Qw=QKVp+(rowbase+q0+wid*QBLK)*QP+qcol;
  const char*Kh=(const char*)(QKVp+(rowbase+kfirst)*QP+kcol);
  const unsigned lds0=(unsigned)(uintptr_t)shm;
  float*wsf=(float*)(shm+LDS_WS)+wid*64;
  const unsigned ksrc=(unsigned)(lane*QP+wid*8)*2u;
  const unsigned vsrc=(unsigned)((16*(wid&3)+(lane>>2))*QP+(wid>>2)*32+(lane&3)*8)*2u;
  const unsigned kdst=lds0+LDS_K+wid*1024, vdst=lds0+LDS_V+wid*1024;
  #define DMA_K(t,slot) glds16<0>(Kh+(long)(t)*(KVBLK*QP*2),ksrc,(unsigned)__builtin_amdgcn_readfirstlane(kdst+(slot)))
  #define DMA_V(t,slot) glds16<0>(Kh+512+(long)(t)*(KVBLK*QP*2),vsrc,(unsigned)__builtin_amdgcn_readfirstlane(vdst+(slot)))
  const int vb0=(int)(lds0+LDS_V)+((lane>>4)&1)*32+(lane&3)*8+(4*hi+((lane&15)>>2))*64;
  const char*Kbase=shm+LDS_K; bf16x8 kf[8];
  const lds_cptr shm3=(lds_cptr)shm; const lds_cptr kp0=shm3+LDS_K+hi*1024+r32*16; const lds_cptr vp0=shm3+LDS_V+((lane>>4)&1)*32+(lane&3)*8+(4*hi+((lane&15)>>2))*64;
  DMA_K(0,0);DMA_V(0,0);DMA_K(1,SLOTB);
  bf16x8 qr[4];
  #pragma unroll
  for(int d0=0;d0<4;++d0)qr[d0]=*reinterpret_cast<const bf16x8*>(&Qw[(long)r32*QP+d0*16+hi*8]);
  float mhat=0.f,l_reg=0.f;f32x16 o[2];o[0]=f32x16{};o[1]=f32x16{};f32x16 negm=f32x16{}; if(MODE==0){asm volatile("":"+v"(negm));}
  const int dq0=q0+wid*QBLK+r32-kfirst;
  #define CMASK(P0,P1,t) do{ if(MODE==1) wmask(P0,P1,dq0-64*(t),hi); }while(0)
  bool resc=false;
  #define START(P0,P1) do{ const float rm=rowmax(P0,P1); resc=false; \
    { const float dl=(MODE==1)?__builtin_fmaxf(rm,-64.f):rm; mhat=fadd_s(mhat,dl); \
      _Pragma("unroll") for(int r=0;r<16;++r){P0[r]=fsub_s(P0[r],dl);P1[r]=fsub_s(P1[r],dl);} \
      if(MODE==0){ _Pragma("unroll") for(int r=0;r<16;++r)negm[r]=-mhat; asm volatile("":"+v"(negm)); } } \
    _Pragma("unroll") for(int r=0;r<16;++r)P0[r]=__builtin_amdgcn_exp2f(P0[r]); }while(0)
  #define RESC() do{ if(resc){ asm volatile("s_waitcnt lgkmcnt(0)":::"memory"); \
      _Pragma("unroll") for(int d_=0;d_<2;++d_) _Pragma("unroll") for(int r=0;r<16;++r)o[d_][r]*=wsf[crow(r,hi)]; } }while(0)
  f32x16 pA0,pA1,pB0,pB1;
  int sl_prev=0,sl_cur=0,sl_next=SLOTB;
  #define ROT() do{sl_prev=sl_cur;sl_cur=sl_next;sl_next=(sl_next==(NSLOT-1)*SLOTB)?0:sl_next+SLOTB;}while(0)
  DMA_K(2,2*SLOTB);
  WAIT_BAR(3);
  qkt(pA0,pA1,Kbase,qr,negm,r32,hi);asm volatile("s_nop 15\n\ts_nop 7":"+v"(pA0),"+v"(pA1));CMASK(pA0,pA1,0);
  START(pA0,pA1);
  _Pragma("unroll") for(int r=0;r<16;++r)pA1[r]=__builtin_amdgcn_exp2f(pA1[r]);
  WAIT_BAR(0);
  DMA_K(3,0);DMA_V(1,SLOTB);
  ROT();
  kload8(kf,kp0+sl_cur);
  WAIT_BAR(2);
  s16x4 vlo[8],vhi[8]; u32x4 pw0,pw1,pw2,pw3;
  #define PKW(P,B) cvtpk_s(P[B],P[B+1])
  #define PAF(k) __builtin_bit_cast(bf16x8,pw##k)
  #define VFR(i) (bf16x8){vlo[i][0],vlo[i][1],vlo[i][2],vlo[i][3],vhi[i][0],vhi[i][1],vhi[i][2],vhi[i][3]}
  #define PIN(x) asm volatile("":"+v"(x))
  #define MX3(a,b,c) __builtin_fmaxf(__builtin_fmaxf((a),(b)),(c))
  #define GAPA(MF,A0,A1,A2,A3,W0,W1,PW) do{ MF; sacc+=A0; sacc+=A1; sacc+=A2; sacc+=A3; PIN(sacc); W0; W1; PIN(PW); SBAR(); }while(0)
  #define EX(v) __builtin_amdgcn_exp2f(v)
  #define GAPB(MF,X,B) do{ MF; X[B]=EX(X[B]); X[B+1]=EX(X[B+1]); X[B+2]=EX(X[B+2]); X[B+3]=EX(X[B+3]); PIN(X); SBAR(); }while(0)
  #define VRD(i) do{ vlo[i]=vtr(vp_+(((i)>>2)*4096+((i)&3)*1024)); vhi[i]=vtr(vp_+(((i)>>2)*4096+((i)&3)*1024+512)); }while(0)
  #define KRD(G,j) do{ if(G){ kload2(kf,kp0+sl_next,j); SBAR(); } }while(0)
  #define STEP(C0,C1,P0,P1,t,GK,GV,GL) do{ SBAR(); \
    const lds_cptr vp_=vp0+sl_prev; \
    VRD(0); SBAR(); float sacc=(P0[0]+P0[1]); \
    GAPA(C0=__builtin_amdgcn_mfma_f32_32x32x16_bf16(kf[0],qr[0],negm,0,0,0), P0[2],P0[3],P0[4],P0[5],     pw0[0]=PKW(P0,0), pw0[1]=PKW(P0,2), pw0); \
    VRD(4); SBAR(); GAPA(C1=__builtin_amdgcn_mfma_f32_32x32x16_bf16(kf[1],qr[0],negm,0,0,0), P0[6],P0[7],P0[8],P0[9],     pw0[2]=PKW(P0,4), pw0[3]=PKW(P0,6), pw0); \
    VRD(1); SBAR(); GAPA(C0=__builtin_amdgcn_mfma_f32_32x32x16_bf16(kf[2],qr[1],C0,0,0,0),   P0[10],P0[11],P0[12],P0[13], pw1[0]=PKW(P0,8), pw1[1]=PKW(P0,10), pw1); \
    VRD(5); SBAR(); GAPA(C1=__builtin_amdgcn_mfma_f32_32x32x16_bf16(kf[3],qr[1],C1,0,0,0),   P0[14],P0[15],P1[0],P1[1],   pw1[2]=PKW(P0,12),pw1[3]=PKW(P0,14), pw1); \
    VRD(2); SBAR(); GAPA(C0=__builtin_amdgcn_mfma_f32_32x32x16_bf16(kf[4],qr[2],C0,0,0,0),   P1[2],P1[3],P1[4],P1[5],     pw2[0]=PKW(P1,0), pw2[1]=PKW(P1,2), pw2); \
    VRD(6); SBAR(); GAPA(C1=__builtin_amdgcn_mfma_f32_32x32x16_bf16(kf[5],qr[2],C1,0,0,0),   P1[6],P1[7],P1[8],P1[9],     pw2[2]=PKW(P1,4), pw2[3]=PKW(P1,6), pw2); \
    VRD(3); SBAR(); GAPA(C0=__builtin_amdgcn_mfma_f32_32x32x16_bf16(kf[6],qr[3],C0,0,0,0),   P1[10],P1[11],P1[12],P1[13], pw3[0]=PKW(P1,8), pw3[1]=PKW(P1,10), pw3); \
    VRD(7); SBAR(); GAPA(C1=__builtin_amdgcn_mfma_f32_32x32x16_bf16(kf[7],qr[3],C1,0,0,0),   P1[14],P1[15],0.f,0.f,       pw3[2]=PKW(P1,12),pw3[3]=PKW(P1,14), pw3); \
    l_reg+=sacc; \
    if(GK){DMA_K((t)+3,sl_cur);} if(GV){DMA_V((t)+1,sl_next);} \
    if(MODE==1){ _Pragma("unroll") for(int r=0;r<16;++r){C0[r]-=mhat;C1[r]-=mhat;} } \
    CMASK(C0,C1,t); \
    { float a=MX3(C0[0],C0[1],C1[0]),b=MX3(C0[2],C0[3],C1[1]); a=MX3(a,C1[2],C1[3]); \
      _Pragma("unroll") for(int r=4;r<16;r+=4){a=MX3(a,C0[r],C0[r+1]);b=MX3(b,C0[r+2],C0[r+3]);a=MX3(a,C1[r],C1[r+1]);b=MX3(b,C1[r+2],C1[r+3]);} \
      float rm=__builtin_fmaxf(a,b); { auto rr=__builtin_amdgcn_permlane32_swap(__float_as_uint(rm),__float_as_uint(rm),false,false); rm=__builtin_fmaxf(__uint_as_float(rr[0]),__uint_as_float(rr[1])); } \
      resc=false; \
      if(__builtin_expect(__any(rm>(float)THRL),0)){ const float dl=__builtin_fmaxf(rm,0.f); mhat+=dl; \
        _Pragma("unroll") for(int r=0;r<16;++r){C0[r]-=dl;C1[r]-=dl;} \
        if(MODE==0){ _Pragma("unroll") for(int r=0;r<16;++r)negm[r]=-mhat; asm volatile("":"+v"(negm)); } \
        const float f=__builtin_amdgcn_exp2f(-dl); l_reg*=f; if(hi==0)wsf[r32]=f; resc=true; } } \
    SBAR(); \
    GAPB(o[0]=__builtin_amdgcn_mfma_f32_32x32x16_bf16(PAF(0),VFR(0),o[0],0,0,0), C0,0); \
    GAPB(o[1]=__builtin_amdgcn_mfma_f32_32x32x16_bf16(PAF(0),VFR(4),o[1],0,0,0), C0,4); \
    KRD(GL,0); GAPB(o[0]=__builtin_amdgcn_mfma_f32_32x32x16_bf16(PAF(1),VFR(1),o[0],0,0,0), C0,8); \
    KRD(GL,1); GAPB(o[1]=__builtin_amdgcn_mfma_f32_32x32x16_bf16(PAF(1),VFR(5),o[1],0,0,0), C0,12); \
    KRD(GL,2); GAPB(o[0]=__builtin_amdgcn_mfma_f32_32x32x16_bf16(PAF(2),VFR(2),o[0],0,0,0), C1,0); \
    KRD(GL,3); GAPB(o[1]=__builtin_amdgcn_mfma_f32_32x32x16_bf16(PAF(2),VFR(6),o[1],0,0,0), C1,4); \
    GAPB(o[0]=__builtin_amdgcn_mfma_f32_32x32x16_bf16(PAF(3),VFR(3),o[0],0,0,0), C1,8); \
    GAPB(o[1]=__builtin_amdgcn_mfma_f32_32x32x16_bf16(PAF(3),VFR(7),o[1],0,0,0), C1,12); \
    }while(0)
  int t=1;
  for(;t+5<NT;t+=2){
    STEP(pB0,pB1,pA0,pA1,t,true,true,true);     WAIT_BAR(2); RESC(); ROT();
    STEP(pA0,pA1,pB0,pB1,t+1,true,true,true);   WAIT_BAR(2); RESC(); ROT();
  }
  #define ENDW(tt) do{ if((tt)+3<NT){WAIT_BAR(2);} else if((tt)+2<NT){WAIT_BAR(1);} else {WAIT_BAR(0);} }while(0)
  for(;t+1<NT;t+=2){
    STEP(pB0,pB1,pA0,pA1,t,(t+3<NT),(t+1<NT),(t+1<NT));       ENDW(t);   RESC(); ROT();
    STEP(pA0,pA1,pB0,pB1,t+1,(t+4<NT),(t+2<NT),(t+2<NT));     ENDW(t+1); RESC(); ROT();
  }
  STEP(pB0,pB1,pA0,pA1,NT-1,false,false,false); RESC();
  { float sacc=pB0[0]+pB0[1]; _Pragma("unroll") for(int r=2;r<16;++r)sacc+=pB0[r]; _Pragma("unroll") for(int r=0;r<16;++r)sacc+=pB1[r]; l_reg+=sacc;
    pw0=(u32x4){PKW(pB0,0),PKW(pB0,2),PKW(pB0,4),PKW(pB0,6)};pw1=(u32x4){PKW(pB0,8),PKW(pB0,10),PKW(pB0,12),PKW(pB0,14)};pw2=(u32x4){PKW(pB1,0),PKW(pB1,2),PKW(pB1,4),PKW(pB1,6)};pw3=(u32x4){PKW(pB1,8),PKW(pB1,10),PKW(pB1,12),PKW(pB1,14)};
    SBAR(); pv(o,vb0+sl_cur,PAF(0),PAF(1),PAF(2),PAF(3)); }
  #undef PKW
  #undef PAF
  #undef VFR
  #undef PIN
  #undef MX3
  #undef GAPA
  #undef GAPB
  #undef EX
  #undef VRD
  #undef KRD
  #undef STEP
  #undef ENDW
  if(MODE==1){ if(hi==0) l_reg+=__builtin_amdgcn_exp2f(sink2-mhat); }
  {auto rr=__builtin_amdgcn_permlane32_swap(__float_as_uint(l_reg),__float_as_uint(l_reg),false,false);l_reg=__uint_as_float(rr[0])+__uint_as_float(rr[1]);}
  if(hi==0)wsf[32+r32]=l_reg;asm volatile("s_waitcnt lgkmcnt(0)":::"memory");
  float rli[16];
  #pragma unroll
  for(int r=0;r<16;++r)rli[r]=__builtin_amdgcn_rcpf(wsf[32+crow(r,hi)]);
  bf16*Ow=O+(rowbase+q0+wid*QBLK)*OP+ocol;
  { bf16*stg=(bf16*)(shm+LDS_OST)+wid*2048;
    #pragma unroll
    for(int r=0;r<16;++r){const int orow=crow(r,hi);
      #pragma unroll
      for(int d0=0;d0<2;++d0)stg[orow*64+d0*32+r32]=__float2bfloat16(o[d0][r]*rli[r]);}
    asm volatile("s_waitcnt lgkmcnt(0)":::"memory");
    #pragma unroll
    for(int i=0;i<4;++i){const int row=i*8+(lane>>3),ch=lane&7; const u32x4 v=*(const u32x4*)(stg+row*64+ch*8); ATTN_STORE16(Ow+(long)row*OP+ch*8,v);} }
  asm volatile("s_waitcnt lgkmcnt(0)\n\ts_barrier":::"memory");
  #undef DMA_K
  #undef DMA_V
  #undef CMASK
  #undef START
  #undef RESC
  #undef ROT
}
constexpr int ATTN_LDS_BYTES=LDS_BYTES;
template<int THRL=8> __device__ __forceinline__ void attn_phase(char*lds,const bf16*QKVp,bf16*O,const float*sink,int vcu,int G,int sel){
  if(sel&1) for(int u=2*vcu;u<512;u+=2*G){
    #pragma unroll 1
    for(int i=0;i<2;++i){ const int uu=u+i,g=uu>>7,b=g>>1,kvh=g&1,hq=(uu>>5)&3,qb=uu&31,h=4*kvh+hq;
      attn_unit<THRL,0>(b,qb*QB,0,SEQ/KVBLK,512+64*h,1024+64*(2+kvh),1280+64*(2+kvh),64*(8+h),0.f,QKVp,O,lds); }
  }
  if(sel&2) for(int u=2*vcu;u<512;u+=2*G){
    #pragma unroll 1
    for(int i=0;i<2;++i){ const int uu=u+i,g=uu>>7,b=g>>1,kvh=g&1,hq=(uu>>5)&3,qb=uu&31,h=4*kvh+hq;
      const int q0=qb*QB; const int kf=(q0-128<0)?0:q0-128, kl=(q0+QB+128>SEQ)?SEQ:q0+QB+128;
      attn_unit<THRL,1>(b,q0,kf,(kl-kf)/KVBLK,64*h,1024+64*kvh,1280+64*kvh,64*h,sink[h]*1.4426950408889634f,QKVp,O,lds); }
  }
}
#undef SBAR
#undef WAIT_BAR
}
#define GAS __attribute__((address_space(1)))
#define LAS __attribute__((address_space(3)))
typedef unsigned short bf16;
typedef unsigned v4u __attribute__((ext_vector_type(4)));
typedef float f32x4 __attribute__((ext_vector_type(4)));
typedef short bf16x8 __attribute__((ext_vector_type(8)));
typedef GAS unsigned gu32;
typedef GAS unsigned long long gu64;
#define RLX_AGENT __ATOMIC_RELAXED, __HIP_MEMORY_SCOPE_AGENT
#define LDS_WAIT() asm volatile("s_waitcnt lgkmcnt(0)" ::: "memory")
#define VM_WAIT() asm volatile("s_waitcnt vmcnt(0)" ::: "memory")
__device__ __forceinline__ unsigned long long rt() { return __builtin_amdgcn_s_memrealtime(); }
__device__ __forceinline__ unsigned f2bf(float f) { unsigned u = __builtin_bit_cast(unsigned, f); return (u + 0x7fffu + ((u >> 16) & 1u)) >> 16; }
__device__ __forceinline__ unsigned pk2(float lo, float hi) { return f2bf(lo) | (f2bf(hi) << 16); }

#define XB_TMO      128
#define XB_XCNT(j)  (256  + 64 * (j))
#define XB_XSUB(j)  (1280 + 64 * (j))
#define XB_XGEN(j)  (2304 + 64 * (j))
#define XB_TOP      3328
#define XB_TOPGEN   3392
#define XCD_BAR_WORDS 3456
#define XB_SPIN_CAP (1u << 18)

__device__ __forceinline__ unsigned xb_ld(unsigned* p)              { return __hip_atomic_load(p, __ATOMIC_RELAXED, __HIP_MEMORY_SCOPE_AGENT); }
__device__ __forceinline__ unsigned xb_add(unsigned* p, unsigned v) { return __hip_atomic_fetch_add(p, v, __ATOMIC_RELAXED, __HIP_MEMORY_SCOPE_AGENT); }
__device__ __forceinline__ unsigned xb_xcc_id() { return (unsigned)__builtin_amdgcn_s_getreg((3 << 11) | 20) & 0xFu; }
#define XB_SPIN(cond, bar) do { unsigned _sp = 0; while (cond) { __builtin_amdgcn_s_sleep(1); \
    if ((++_sp & 255u) == 0u) { if (xb_ld(&(bar)[XB_TMO])) break; if (_sp > XB_SPIN_CAP) { atomicAdd(&(bar)[XB_TMO], 1u); break; } } } } while (0)

struct XcdBarrier {
    unsigned* bar; unsigned x;
    volatile LAS unsigned* st;
};

__device__ __forceinline__ XcdBarrier xcd_barrier_post(unsigned* bar, volatile LAS unsigned* st) {
    XcdBarrier b; b.bar = bar; b.x = xb_xcc_id(); b.st = st;
    if (threadIdx.x == 0) (void)xb_add(&bar[XB_XCNT(b.x)], 1u);
    return b;
}
__device__ __forceinline__ void xcd_barrier_complete(unsigned* bar, unsigned x, unsigned& nloc, unsigned& nx) {
    const unsigned G = gridDim.x * gridDim.y * gridDim.z;
    unsigned sum, cnt, mine, sp = 0u;
    for (;;) {
        sum = 0u; cnt = 0u; mine = 0u;
#pragma unroll
        for (unsigned j = 0; j < 16; ++j) { const unsigned c = xb_ld(&bar[XB_XCNT(j)]); sum += c; cnt += (c > 0u) ? 1u : 0u; mine = (j == x) ? c : mine; }
        if (sum == G) break;
        __builtin_amdgcn_s_sleep(1);
        if ((++sp & 255u) == 0u) { if (xb_ld(&bar[XB_TMO])) break; if (sp > XB_SPIN_CAP) { atomicAdd(&bar[XB_TMO], 1u); break; } }
    }
    nloc = mine > 0u ? mine : 1u; nx = cnt > 0u ? cnt : 1u;
}

__device__ __forceinline__ void xcd_barrier(const XcdBarrier& b) {
    asm volatile("s_waitcnt vmcnt(0)" ::: "memory");
    __syncthreads();
    if (threadIdx.x == 0) {
        unsigned* bar = b.bar;
        __builtin_amdgcn_s_waitcnt(0);
        unsigned nloc = b.st[0], nx = b.st[1];
        if (nloc == 0u) { xcd_barrier_complete(bar, b.x, nloc, nx); b.st[0] = nloc; b.st[1] = nx; }
        const unsigned old = xb_add(&bar[XB_XSUB(b.x)], 1u);
        const unsigned gen = old / nloc;
        if (old + 1u == (gen + 1u) * nloc) {
            __builtin_amdgcn_fence(__ATOMIC_RELEASE, "agent");
            asm volatile("s_waitcnt vmcnt(0)" ::: "memory");
            const unsigned og = xb_add(&bar[XB_TOP], 1u);
            const unsigned tg = og / nx;
            if (og + 1u == (tg + 1u) * nx) xb_add(&bar[XB_TOPGEN], 1u);
            else XB_SPIN(xb_ld(&bar[XB_TOPGEN]) == tg, bar);
            __builtin_amdgcn_fence(__ATOMIC_ACQUIRE, "agent");
            xb_add(&bar[XB_XGEN(b.x)], 1u);
            asm volatile("s_waitcnt vmcnt(0)" ::: "memory");
        } else {
            XB_SPIN(xb_ld(&bar[XB_XGEN(b.x)]) == gen, bar);
            __builtin_amdgcn_fence(__ATOMIC_ACQUIRE, "agent");
            asm volatile("s_waitcnt vmcnt(0)" ::: "memory");
        }
    }
    __syncthreads();
}

constexpr int NWAVES = 8, NTHREADS = NWAVES * 64;
constexpr int SEQ = 8192, DM = 1024, M = 2 * SEQ;
constexpr int AB_IN = 1536, DFF = 3584, C_IN = 4128, NEXP = 8;
constexpr float EPS = 1e-6f;
constexpr float QSCALE = 0.125f * 1.4426950408889634f;
constexpr int XRP = 2048;
constexpr int MOE_MAXROWS = 135 * 256;

constexpr size_t MiB = 1u << 20;
constexpr size_t WS_CTL = 0, CTL_ZERO_BYTES = 32 * 1024;
constexpr size_t WS_SMALL = 1 * MiB;
constexpr size_t SM_GAINS = WS_SMALL, SM_WG = WS_SMALL + 4096, SM_WR = WS_SMALL + 256 * 1024, SM_HIST = WS_SMALL + 512 * 1024, SM_META = WS_SMALL + 640 * 1024;
constexpr size_t WS_TAB = 2 * MiB;
constexpr size_t WS_W_ABIN = 6 * MiB, WS_W_ABOUT = 9 * MiB, WS_W_FGU = 11 * MiB, WS_W_FD = 25 * MiB, WS_W_CIN = 32 * MiB, WS_W_COUT = 40 * MiB;
constexpr size_t WS_XN = 42 * MiB;
constexpr size_t WS_GATES = 74 * MiB;
constexpr size_t WS_SSP1 = 78 * MiB, WS_SSP2 = 79 * MiB;
constexpr size_t WS_GF = 76 * MiB, WS_GB = WS_GF + 512 * 1024, WS_BF = WS_GB + 512 * 1024, WS_BB = WS_BF + 512 * 1024;
constexpr size_t WS_QKV = 80 * MiB, WS_O = 128 * MiB, WS_ACT = 160 * MiB;
constexpr size_t WS_PROJ = 80 * MiB  , WS_Z = 176 * MiB, WS_CQ = 208 * MiB, WS_CK = 240 * MiB, WS_CV = 272 * MiB, WS_OG = 272 * MiB  ;
constexpr size_t WS_GKT = 80 * MiB, WS_GTP = 144 * MiB  , WS_GQKM = 80 * MiB  , WS_GVT = 368 * MiB, WS_GSC = 2 * MiB  , WS_OF = 304 * MiB, WS_OB = 112 * MiB;
constexpr size_t WS_XG = 2 * MiB, WS_W_MGU = WS_XG + (size_t)MOE_MAXROWS * 2048, WS_MISC2 = 230 * MiB, WS_ACTG = 235 * MiB + 512 * 1024, WS_XN2 = 240 * MiB;
constexpr size_t WS_TOPI = WS_MISC2, WS_TOPG = WS_MISC2 + 256 * 1024, WS_POS = WS_MISC2 + 512 * 1024;
constexpr size_t WS_W_MD = 181 * MiB + 512 * 1024, WS_W_MD_B = 2 * MiB, WS_Y = 58 * MiB, WS_YT = 20 * MiB; constexpr int MD_EARLY = 6;
constexpr int MOE_MAXSUB = 144;
constexpr size_t WS_END = WS_ACTG + (size_t)MOE_MAXROWS * DFF * 2;
static_assert(WS_W_MGU + (size_t)NEXP * 7168 * 1024 * 2 <= WS_MISC2 && WS_Y + (size_t)MOE_MAXROWS * 4096 <= WS_MISC2 && WS_W_MD >= WS_W_MGU + (size_t)NEXP * 7168 * 1024 * 2 && WS_W_MD + (size_t)MD_EARLY * 1024 * DFF * 2 <= WS_MISC2 && WS_W_MD_B + (size_t)(NEXP - MD_EARLY) * 1024 * DFF * 2 <= WS_YT && WS_YT + (size_t)MOE_MAXSUB * 262144 <= WS_Y, "moe map");
constexpr int CW_TMO = 0, CW_CODE = 1, CW_P10B = 2048, CW_CONV = 2112, CW_BAR = 4096;

constexpr int RING_OFF = 0, RING_BYTES = 131072, LDSCTL_OFF = RING_BYTES, MISC_OFF = LDSCTL_OFF + 320, LDS_BYTES = 163840;

__device__ __forceinline__ float bf2f(unsigned short v) { return __uint_as_float((unsigned)v << 16); }
__device__ __forceinline__ float bflo(unsigned w) { return __uint_as_float(w << 16); }
__device__ __forceinline__ float bfhi(unsigned w) { return __uint_as_float(w & 0xffff0000u); }
__device__ __forceinline__ float wave_sum(float v) {
#pragma unroll
    for (int o = 1; o < 64; o <<= 1) v += __shfl_xor(v, o);
    return v;
}

struct Frame {
    LAS unsigned char* lds; volatile LAS unsigned* MISC; gu32* ctl;
    int tid, lane, wave, vcu, G;
    unsigned char* ws; float* out;
};
struct Args { const float* in[27]; float* out; unsigned char* ws; int ph_lo, ph_hi, use_bar, pad; };

__device__ __forceinline__ int abmap(int n) {
    int tile, wc, p; bool tb = false; int d = n & 63;
    if (n < 512) { const int h = n >> 6; tile = h >> 2; wc = h & 3; }
    else if (n < 640) { tile = 4; wc = (n - 512) >> 6; }
    else if (n < 768) { tile = 5; wc = (n - 640) >> 6; }
    else if (n < 1280) { const int h = (n - 768) >> 6; tile = 2 + (h >> 2); wc = h & 3; tb = true; }
    else if (n < 1408) { tile = 4; wc = 2 + ((n - 1280) >> 6); tb = true; }
    else { tile = 5; wc = 2 + ((n - 1408) >> 6); }
    p = d; if (tb) { if (d >= 16 && d < 32) p = d + 16; else if (d >= 32 && d < 48) p = d - 16; }
    return 256 * tile + 128 * (p >> 5) + 32 * wc + (p & 31);
}
__device__ __forceinline__ int posdim_b(int p) { return (p >= 16 && p < 32) ? p + 16 : (p >= 32 && p < 48) ? p - 16 : p; }
__device__ __forceinline__ int gumap(int j, int up) { return 256 * (j >> 7) + 128 * up + (j & 127); }

template <int MODE>
__device__ __forceinline__ void transpose_item(const float* W, int K, int ldw, int nblk, bf16* WT, const float* gain, int gmask, int item, int lane) {
    const int kb = item / nblk, nb = item % nblk, kr = lane >> 4, nc = lane & 15, k0 = 64 * kb + 16 * kr, n0 = 64 * nb + 4 * nc;
    const GAS f32x4* src = (const GAS f32x4*)(W + (size_t)k0 * ldw + n0);
    f32x4 v[16];
#pragma unroll
    for (int i = 0; i < 16; ++i) v[i] = __builtin_nontemporal_load(src + (size_t)i * (ldw / 4));
    if (gain) {
        const float cs = MODE == 2 ? -1.4426950408889634f : MODE == 3 ? -0.6931471805599453f : 1.f;
#pragma unroll
        for (int q = 0; q < 4; ++q) { f32x4 g = *(const GAS f32x4*)(gain + ((k0 + 4 * q) & gmask)); if (MODE >= 2) g = g * cs;
            v[4 * q] = v[4 * q] * g.x; v[4 * q + 1] = v[4 * q + 1] * g.y; v[4 * q + 2] = v[4 * q + 2] * g.z; v[4 * q + 3] = v[4 * q + 3] * g.w; } }
#pragma unroll
    for (int j = 0; j < 4; ++j) { const int nn = n0 + j; const int row = MODE == 0 ? nn : MODE == 1 ? abmap(nn) : MODE == 2 ? gumap(nn, 0) : gumap(nn, 1);
        GAS v4u* dst = (GAS v4u*)(WT + (size_t)row * K + k0);
#pragma unroll
        for (int p = 0; p < 2; ++p) { v4u o; o.x = pg8::cvt_pk_bf16(v[8 * p][j], v[8 * p + 1][j]); o.y = pg8::cvt_pk_bf16(v[8 * p + 2][j], v[8 * p + 3][j]); o.z = pg8::cvt_pk_bf16(v[8 * p + 4][j], v[8 * p + 5][j]); o.w = pg8::cvt_pk_bf16(v[8 * p + 6][j], v[8 * p + 7][j]); dst[p] = o; } }
}
__device__ __forceinline__ float rms_row_to_bf16(int lane, const float* xrow, bf16* orow) {
    const GAS f32x4* xr = (const GAS f32x4*)xrow + lane;
    f32x4 v[4]; float s = 0.f;
#pragma unroll
    for (int j = 0; j < 4; ++j) { v[j] = xr[64 * j]; s += (v[j].x * v[j].x + v[j].y * v[j].y) + (v[j].z * v[j].z + v[j].w * v[j].w); }
    const float rstd = 1.f / sqrtf(wave_sum(s) * (1.f / DM) + EPS);
    GAS unsigned long long* o8 = (GAS unsigned long long*)orow + lane;
#pragma unroll
    for (int j = 0; j < 4; ++j) o8[64 * j] = (unsigned long long)pk2(v[j].x * rstd, v[j].y * rstd) | ((unsigned long long)pk2(v[j].z * rstd, v[j].w * rstd) << 32);
    return rstd;
}

__device__ __forceinline__ void rms_rows4(int lane, const float* x, bf16* xn, int m0, int mstride) {
    f32x4 v[4][4];
#pragma unroll
    for (int r = 0; r < 4; ++r) { const GAS f32x4* xr = (const GAS f32x4*)(x + (size_t)(m0 + r * mstride) * DM) + lane;
#pragma unroll
        for (int j = 0; j < 4; ++j) v[r][j] = xr[64 * j]; }
#pragma unroll
    for (int r = 0; r < 4; ++r) { float s = 0.f;
#pragma unroll
        for (int j = 0; j < 4; ++j) s += (v[r][j].x * v[r][j].x + v[r][j].y * v[r][j].y) + (v[r][j].z * v[r][j].z + v[r][j].w * v[r][j].w);
        const float rstd = 1.f / sqrtf(wave_sum(s) * (1.f / DM) + EPS);
        GAS unsigned long long* o8 = (GAS unsigned long long*)(xn + (size_t)(m0 + r * mstride) * DM) + lane;
#pragma unroll
        for (int j = 0; j < 4; ++j) o8[64 * j] = (unsigned long long)pg8::cvt_pk_bf16(v[r][j].x * rstd, v[r][j].y * rstd) | ((unsigned long long)pg8::cvt_pk_bf16(v[r][j].z * rstd, v[r][j].w * rstd) << 32); }
}
__device__ __forceinline__ void rms_rows4b(int lane, const bf16* xr, bf16* xn, int m0, int mstride) {
    v4u v[4][2];
#pragma unroll
    for (int r = 0; r < 4; ++r) { const GAS v4u* p = (const GAS v4u*)(xr + (size_t)(m0 + r * mstride) * XRP) + lane; v[r][0] = p[0]; v[r][1] = p[64]; }
#pragma unroll
    for (int r = 0; r < 4; ++r) { float f[16]; float s = 0.f;
#pragma unroll
        for (int q = 0; q < 2; ++q)
#pragma unroll
            for (int e = 0; e < 4; ++e) { f[8 * q + 2 * e] = bflo(v[r][q][e]); f[8 * q + 2 * e + 1] = bfhi(v[r][q][e]); }
#pragma unroll
        for (int e = 0; e < 16; ++e) s += f[e] * f[e];
        const float rstd = 1.f / sqrtf(wave_sum(s) * (1.f / DM) + EPS);
        GAS v4u* o = (GAS v4u*)(xn + (size_t)(m0 + r * mstride) * DM) + lane;
#pragma unroll
        for (int q = 0; q < 2; ++q) { v4u w;
#pragma unroll
            for (int e = 0; e < 4; ++e) w[e] = pg8::cvt_pk_bf16(f[8 * q + 2 * e] * rstd, f[8 * q + 2 * e + 1] * rstd);
            o[64 * q] = w; } }
}
__device__ __forceinline__ void p0_prologue(Frame& F, const Args& A) {
    const int gw = F.vcu * NWAVES + F.wave, NGW = F.G * NWAVES, lane = F.lane;
    unsigned char* ws = F.ws;
#define in A.in
    constexpr int I_ABIN = 16 * 24, I_ABOUT = 16 * 16;
    for (int it = gw; it < I_ABIN + I_ABOUT; it += NGW) {
        if (it < I_ABIN) transpose_item<1>(in[2], 1024, AB_IN, 24, (bf16*)(ws + WS_W_ABIN), in[1], 1023, it, lane);
        else transpose_item<0>(in[8], 1024, 1024, 16, (bf16*)(ws + WS_W_ABOUT), nullptr, 0, it - I_ABIN, lane);
    }
    const int gt = gw * 64 + lane, NGT = NGW * 64;
    float* tab1 = (float*)(ws + WS_TAB); float* tab2 = tab1 + 2 * 8192 * 32;
    for (int i = gt; i < 8192 * 32; i += NGT) { const int t = i >> 5, f = i & 31;
        { const float inv = exp2f(-13.287712379549449f * (float)(2 * f) * (1.0f / 64.0f)); const float ang = (float)t * inv;
          const double rev = (double)ang * 0.15915494309189535; const float fr = (float)(rev - __builtin_rint(rev)); tab1[i] = __builtin_amdgcn_cosf(fr); tab1[8192 * 32 + i] = __builtin_amdgcn_sinf(fr); }
        { const int ff = f & 15; const float inv = exp2f(-13.287712379549449f * (float)(2 * ff) * (1.0f / 32.0f)); const float pos = (f < 16) ? (float)(t >> 6) : (float)(t & 63); const float ang = pos * inv;
          const double rev = (double)ang * 0.15915494309189535; const float fr = (float)(rev - __builtin_rint(rev)); tab2[i] = __builtin_amdgcn_cosf(fr); tab2[8192 * 32 + i] = __builtin_amdgcn_sinf(fr); }
    }
    float* gains = (float*)(ws + SM_GAINS);
    for (int i = gt; i < 256; i += NGT) { const int sel = i >> 6, p = i & 63; float v;
        if (sel == 0) v = in[3][p]; else if (sel == 1) v = in[4][p]; else if (sel == 2) v = in[6][posdim_b(p)]; else v = in[7][posdim_b(p)];
        gains[i] = v; }
    float* wg = (float*)(ws + SM_WG);
    for (int i = gt; i < 1024 * 32; i += NGT) { const int k = i >> 5, j = i & 31; wg[((k >> 2) * 32 + j) * 4 + (k & 3)] = in[13][k] * in[14][(size_t)k * C_IN + 4096 + j]; }
    { bf16* wrb = (bf16*)(ws + SM_WR);
      for (int i = gt; i < 32 * 64 * 8; i += NGT) { const int s_ = i >> 9, L = (i >> 3) & 63, j = i & 7, k = 32 * s_ + 8 * (L >> 4) + j, n = L & 15;
          const float w = n < 8 ? in[22][k] * in[23][k * 8 + n] : 0.f;
          const unsigned h0 = f2bf(w); const float r1 = w - __uint_as_float(h0 << 16); const unsigned h1 = f2bf(r1); const float r2 = r1 - __uint_as_float(h1 << 16); const unsigned h2 = f2bf(r2);
          wrb[((size_t)(s_ * 3 + 0) * 64 + L) * 8 + j] = (bf16)h0; wrb[((size_t)(s_ * 3 + 1) * 64 + L) * 8 + j] = (bf16)h1; wrb[((size_t)(s_ * 3 + 2) * 64 + L) * 8 + j] = (bf16)h2; } }
    for (int m = gw; m + 3 * NGW < M; m += 4 * NGW) rms_rows4(lane, in[0], (bf16*)(ws + WS_XN), m, NGW);
#undef in
}
__device__ __forceinline__ void p1_deferred(Frame& F, const Args& A, int widx, int nw) {
    unsigned char* ws = F.ws; const int lane = F.lane;
    constexpr int I_G = 16 * 56, I_FD = 56 * 16, I_CIN = 16 * 64, I_COUT = 16 * 16;
    constexpr int NITEMS = 2 * I_G + I_FD + I_CIN + I_COUT;
    for (int it = widx; it < NITEMS; it += nw) {
        int r = it;
        if (r < I_G) { transpose_item<2>(A.in[10], 1024, DFF, 56, (bf16*)(ws + WS_W_FGU), A.in[9], 1023, r, lane); continue; } r -= I_G;
        if (r < I_G) { transpose_item<3>(A.in[11], 1024, DFF, 56, (bf16*)(ws + WS_W_FGU), A.in[9], 1023, r, lane); continue; } r -= I_G;
        if (r < I_FD) { transpose_item<0>(A.in[12], DFF, 1024, 16, (bf16*)(ws + WS_W_FD), nullptr, 0, r, lane); continue; } r -= I_FD;
        if (r < I_CIN) { transpose_item<0>(A.in[14], 1024, C_IN, 64, (bf16*)(ws + WS_W_CIN), A.in[13], 1023, r, lane); continue; } r -= I_CIN;
        transpose_item<0>(A.in[21], 1024, 1024, 16, (bf16*)(ws + WS_W_COUT), A.in[20], 127, r, lane);
    }
}


__device__ __forceinline__ void phase_rms(Frame& F, const bf16* xr, bf16* xn) {
    const int gw = F.vcu * NWAVES + F.wave, NGW = F.G * NWAVES;
    for (int m = gw; m + 3 * NGW < M; m += 4 * NGW) rms_rows4b(F.lane, xr, xn, m, NGW);
}
typedef float f32x16 __attribute__((ext_vector_type(16)));
__device__ __forceinline__ void gates_blocks(Frame& F, const bf16* x, const float* wg, int rb0, float* gout, LAS float* lds_out) {
    const int lane = F.lane, i = lane & 31, h = lane >> 5, w = F.wave, kq = w & 3;
    LAS float* red = (LAS float*)(F.lds + RING_OFF);
    const int rb = rb0 + (w >> 2);
    const bf16* xr = x + (size_t)(rb * 32 + i) * XRP + 256 * kq + 4 * h; const float* wp = wg + (size_t)(64 * kq) * 128 + (size_t)(h * 32 + i) * 4;
    f32x16 acc; for (int r = 0; r < 16; ++r) acc[r] = 0.f; float ss = 0.f;
#pragma unroll 8
    for (int c = 0; c < 32; ++c) {
        typedef unsigned u32x2g __attribute__((ext_vector_type(2))); const u32x2g aw = *(const GAS u32x2g*)(xr + 8 * c); const f32x4 a = (f32x4){bflo(aw.x), bfhi(aw.x), bflo(aw.y), bfhi(aw.y)}, b = *(const GAS f32x4*)(wp + (size_t)c * 256);
        ss += (a.x * a.x + a.y * a.y) + (a.z * a.z + a.w * a.w);
        acc = __builtin_amdgcn_mfma_f32_32x32x2f32(a.x, b.x, acc, 0, 0, 0); acc = __builtin_amdgcn_mfma_f32_32x32x2f32(a.y, b.y, acc, 0, 0, 0);
        acc = __builtin_amdgcn_mfma_f32_32x32x2f32(a.z, b.z, acc, 0, 0, 0); acc = __builtin_amdgcn_mfma_f32_32x32x2f32(a.w, b.w, acc, 0, 0, 0);
    }
    ss += __shfl_xor(ss, 32);
#pragma unroll
    for (int r = 0; r < 16; ++r) red[(w * 17 + r) * 64 + lane] = acc[r];
    red[(w * 17 + 16) * 64 + lane] = ss;
    __syncthreads();
    if (kq == 0) {
        float s4 = 0.f;
#pragma unroll
        for (int q = 0; q < 4; ++q) s4 += red[((w + q) * 17 + 16) * 64 + lane];
        const float rstd = 1.f / sqrtf(s4 * (1.f / DM) + EPS);
#pragma unroll
        for (int r = 0; r < 16; ++r) { float a = 0.f;
#pragma unroll
            for (int q = 0; q < 4; ++q) a += red[((w + q) * 17 + r) * 64 + lane];
            const int row = (r & 3) + 8 * (r >> 2) + 4 * h; const float rs = __shfl(rstd, row);
            if (lds_out) { if (i < 8) lds_out[((w >> 2) * 32 + row) * 8 + i] = a * rs; } else gout[(size_t)(rb * 32 + row) * 32 + i] = a * rs; }
    }
    __syncthreads();
}
__device__ __forceinline__ void phase_gates(Frame& F, const bf16* x, float* gates) {
    for (int rb0 = 2 * F.vcu; rb0 < M / 32; rb0 += 2 * F.G) gates_blocks(F, x, (const float*)(F.ws + SM_WG), rb0, gates, nullptr);
}

__device__ __forceinline__ void phase_conv(Frame& F, const Args& A, bool own_chunk) {
    const int gw = F.vcu * NWAVES + F.wave, NGW = F.G * NWAVES, lane = F.lane;
    const bf16* proj = (const bf16*)(F.ws + WS_PROJ); const float* cw = A.in[15];
    for (int it = own_chunk ? F.wave : gw; it < (own_chunk ? 24 : 1024 * 6); it += (own_chunk ? NWAVES : NGW)) {
        const int run = own_chunk ? F.vcu * 4 + it / 6 : it / 6, sh = it % 6, s = sh >> 1, hh = sh & 1;
        const int cb = 1024 * s + 512 * hh + 8 * lane;
        const bf16* projs = proj + (size_t)s * M * 1024 + 512 * hh + 8 * lane;
        bf16* dst = (bf16*)(F.ws + (s == 0 ? WS_CQ : s == 1 ? WS_CK : WS_CV)) + 512 * hh + 8 * lane;
        float w[5][8];
#pragma unroll
        for (int j = 0; j < 5; ++j) { const f32x4 a = *(const f32x4*)(cw + j * 3072 + cb), b = *(const f32x4*)(cw + j * 3072 + cb + 4); w[j][0] = a.x; w[j][1] = a.y; w[j][2] = a.z; w[j][3] = a.w; w[j][4] = b.x; w[j][5] = b.y; w[j][6] = b.z; w[j][7] = b.w; }
        const int row0 = run * 16, t0 = row0 & (SEQ - 1);
        v4u raw[20];
#pragma unroll
        for (int i = 0; i < 20; ++i) { const int tt = t0 - 2 + i; if (tt < 0 || tt >= SEQ) raw[i] = (v4u){0u, 0u, 0u, 0u}; else raw[i] = __builtin_nontemporal_load((const GAS v4u*)(projs + (size_t)(row0 - 2 + i) * 1024)); }
#pragma unroll
        for (int q = 0; q < 16; ++q) {
            float y[8]; float ss = 0.f;
#pragma unroll
            for (int e = 0; e < 8; ++e) { float a = 0.f;
#pragma unroll
                for (int j = 0; j < 5; ++j) { const unsigned wd = raw[q + j][e >> 1]; a += w[j][e] * ((e & 1) ? bfhi(wd) : bflo(wd)); }
                a = a / (1.0f + __expf(-a)); y[e] = a; ss += a * a; }
            float sc = 1.f;
            if (s < 2) { ss += __shfl_xor(ss, 1); ss += __shfl_xor(ss, 2); ss += __shfl_xor(ss, 4); ss += __shfl_xor(ss, 8); sc = (1.f / sqrtf(ss + EPS)) * (s == 0 ? 0.08838834764831845f : 1.f); }
            v4u o; o.x = pk2(y[0] * sc, y[1] * sc); o.y = pk2(y[2] * sc, y[3] * sc); o.z = pk2(y[4] * sc, y[5] * sc); o.w = pk2(y[6] * sc, y[7] * sc);
            *(GAS v4u*)(dst + (size_t)(row0 + q) * 1024) = o;
        }
    }
    const float* gates = (const float*)(F.ws + WS_GATES);
    float* GFp = (float*)(F.ws + WS_GF); float* GBp = (float*)(F.ws + WS_GB); float* BFp = (float*)(F.ws + WS_BF); float* BBp = (float*)(F.ws + WS_BB);
    const int gt = own_chunk ? F.vcu * 512 + F.tid : gw * 64 + lane, NGT = own_chunk ? M * 8 : NGW * 64;
    for (int i = gt; i < M * 8; i += NGT) { const int row = i >> 3, hd = i & 7; const float* gr = gates + (size_t)row * 32;
        { const float xx = gr[hd] + A.in[17][hd]; const float sp = xx > 20.f ? xx : log1pf(__expf(xx)); GFp[i] = -__expf(A.in[16][hd]) * sp; BFp[i] = 1.f / (1.f + __expf(-gr[8 + hd])); }
        { const float xx = gr[16 + hd] + A.in[19][hd]; const float sp = xx > 20.f ? xx : log1pf(__expf(xx)); GBp[i] = -__expf(A.in[18][hd]) * sp; BBp[i] = 1.f / (1.f + __expf(-gr[24 + hd])); }
    }
}

__device__ __forceinline__ void phase_onorm(Frame& F) {
    const int gw = F.vcu * NWAVES + F.wave, NGW = F.G * NWAVES, lane = F.lane;
    const bf16* of = (const bf16*)(F.ws + WS_OF); const bf16* ob = (const bf16*)(F.ws + WS_OB); const bf16* zb = (const bf16*)(F.ws + WS_Z); bf16* og = (bf16*)(F.ws + WS_OG);
    for (int m0 = gw; m0 + 3 * NGW < M; m0 += 4 * NGW) {
        v4u ra[4][2], rb[4][2], rc[4][2];
#pragma unroll
        for (int q = 0; q < 4; ++q)
#pragma unroll
            for (int hlf = 0; hlf < 2; ++hlf) { const size_t off = (size_t)(m0 + q * NGW) * 1024 + 16 * lane + 8 * hlf; ra[q][hlf] = __builtin_nontemporal_load((const GAS v4u*)(of + off)); rb[q][hlf] = __builtin_nontemporal_load((const GAS v4u*)(ob + off)); rc[q][hlf] = __builtin_nontemporal_load((const GAS v4u*)(zb + off)); }
#pragma unroll
        for (int q = 0; q < 4; ++q) {
            float o[16], z[16]; float ss = 0.f;
#pragma unroll
            for (int hlf = 0; hlf < 2; ++hlf)
#pragma unroll
                for (int e = 0; e < 4; ++e) { const unsigned a = ra[q][hlf][e], b = rb[q][hlf][e], c = rc[q][hlf][e];
                    o[8 * hlf + 2 * e] = bflo(a) + bflo(b); o[8 * hlf + 2 * e + 1] = bfhi(a) + bfhi(b); z[8 * hlf + 2 * e] = bflo(c); z[8 * hlf + 2 * e + 1] = bfhi(c); }
#pragma unroll
            for (int e = 0; e < 16; ++e) ss += o[e] * o[e];
            ss += __shfl_xor(ss, 1); ss += __shfl_xor(ss, 2); ss += __shfl_xor(ss, 4);
            const float r = 1.f / sqrtf(ss * (1.f / 128.f) + EPS);
            unsigned w[8];
#pragma unroll
            for (int e = 0; e < 8; ++e) { const float a = o[2 * e] * r * pg8::silu_f(z[2 * e]), b = o[2 * e + 1] * r * pg8::silu_f(z[2 * e + 1]); w[e] = pg8::cvt_pk_bf16(a, b); }
            GAS v4u* dst = (GAS v4u*)(og + (size_t)(m0 + q * NGW) * 1024 + 16 * lane); dst[0] = (v4u){w[0], w[1], w[2], w[3]}; dst[1] = (v4u){w[4], w[5], w[6], w[7]};
        }
    }
}

__device__ __forceinline__ void phase_cvt_mgu(Frame& F, const Args& A) {
    const int gw = F.vcu * NWAVES + F.wave, NGW = F.G * NWAVES;
    constexpr int I_G = 16 * 56;
    for (int it = gw; it < NEXP * 2 * I_G; it += NGW) { const int e = it / (2 * I_G), r = it % (2 * I_G); bf16* dst = (bf16*)(F.ws + WS_W_MGU) + (size_t)e * 7168 * 1024;
        if (r < I_G) transpose_item<2>(A.in[24] + (size_t)e * 1024 * DFF, 1024, DFF, 56, dst, A.in[22], 1023, r, F.lane);
        else transpose_item<3>(A.in[25] + (size_t)e * 1024 * DFF, 1024, DFF, 56, dst, A.in[22], 1023, r - I_G, F.lane); }
}
__device__ __forceinline__ void cvt_md_items(Frame& F, const Args& A, int gw, int NGW, int e_lo, int e_hi) {
    constexpr int I_D = 56 * 16;
    for (int it = e_lo * I_D + gw; it < e_hi * I_D; it += NGW) { const int e = it / I_D, r = it % I_D;
        bf16* dst = e < MD_EARLY ? (bf16*)(F.ws + WS_W_MD) + (size_t)e * 1024 * DFF : (bf16*)(F.ws + WS_W_MD_B) + (size_t)(e - MD_EARLY) * 1024 * DFF;
        transpose_item<0>(A.in[26] + (size_t)e * DFF * 1024, DFF, 1024, 16, dst, nullptr, 0, r, F.lane); }
}
__device__ __forceinline__ void phase_cvt_md(Frame& F, const Args& A) {
    if (blockIdx.x == 0) { int* meta = (int*)(F.ws + SM_META); int* tidx = meta + 16;
        pg8::MoeOrder S; S.init(meta, DM, F.G, 0, DFF, true, MOE_MAXSUB);
        for (int i = F.tid; i < 136 * 4; i += NTHREADS) tidx[i] = -1;
        __syncthreads();
        if (S.P > 1) for (int t = F.tid; t < S.T; t += NTHREADS) { pg8::Unit u; S.unit_at(S.R * S.G + t, u); tidx[u.pm * 4 + u.pn] = t; }
        if (F.tid == 0) { meta[9] = S.P > 1 ? S.T : 0; meta[10] = S.P; } }
    cvt_md_items(F, A, F.vcu * NWAVES + F.wave, F.G * NWAVES, MD_EARLY, NEXP);
}
__device__ __forceinline__ void router_logits_tile(Frame& F, const bf16* x3, int tile, LAS float* lg) {
    typedef float f32x4r __attribute__((ext_vector_type(4)));
    const int L = F.lane, w = F.wave, m = L & 15, g = L >> 4;
    LAS float* red = (LAS float*)(F.lds + RING_OFF);
    LAS float* rss = red + 8 * 4 * 4 * 64;
    const bf16* wrb = (const bf16*)(F.ws + SM_WR);
    bf16x8 a[4][4], b[4][3];
#pragma unroll
    for (int mt = 0; mt < 4; ++mt)
#pragma unroll
        for (int s_ = 0; s_ < 4; ++s_) a[mt][s_] = *(const GAS bf16x8*)(x3 + (size_t)(tile * 64 + 16 * mt + m) * XRP + 32 * (4 * w + s_) + 8 * g);
#pragma unroll
    for (int s_ = 0; s_ < 4; ++s_)
#pragma unroll
        for (int t = 0; t < 3; ++t) b[s_][t] = *(const GAS bf16x8*)(wrb + ((size_t)((4 * w + s_) * 3 + t) * 64 + L) * 8);
#pragma unroll
    for (int mt = 0; mt < 4; ++mt) { f32x4r acc = (f32x4r){0.f, 0.f, 0.f, 0.f}; float ss = 0.f;
#pragma unroll
        for (int s_ = 0; s_ < 4; ++s_) {
#pragma unroll
            for (int t = 0; t < 3; ++t) acc = __builtin_amdgcn_mfma_f32_16x16x32_bf16(a[mt][s_], b[s_][t], acc, 0, 0, 0);
#pragma unroll
            for (int j = 0; j < 8; ++j) { const float v = __uint_as_float(((unsigned)(unsigned short)a[mt][s_][j]) << 16); ss += v * v; } }
#pragma unroll
        for (int r = 0; r < 4; ++r) red[((w * 4 + mt) * 4 + r) * 64 + L] = acc[r];
        rss[(w * 4 + mt) * 64 + L] = ss; }
    __syncthreads();
    if (w < 4) { const int mt = w;
        float st = 0.f;
#pragma unroll
        for (int ww = 0; ww < 8; ++ww)
#pragma unroll
            for (int gg = 0; gg < 4; ++gg) st += rss[(ww * 4 + mt) * 64 + 16 * gg + m];
        const float rstd = 1.f / sqrtf(st * (1.f / DM) + EPS);
#pragma unroll
        for (int r = 0; r < 4; ++r) { float v = 0.f;
#pragma unroll
            for (int ww = 0; ww < 8; ++ww) v += red[((ww * 4 + mt) * 4 + r) * 64 + L];
            const float rs = __shfl(rstd, 4 * g + r);
            if (m < 8) lg[(16 * mt + 4 * g + r) * 8 + m] = v * rs; } }
    __syncthreads();
}
__device__ __forceinline__ void phase_route_a(Frame& F) {
    LAS float* lg = (LAS float*)(F.lds + RING_OFF + 40 * 1024);
    const bf16* x3 = (const bf16*)F.out; bf16* xn = (bf16*)(F.ws + WS_XN2);
    int* topi = (int*)(F.ws + WS_TOPI); float* topg = (float*)(F.ws + WS_TOPG); int* histg = (int*)(F.ws + SM_HIST);
    const int lane = F.lane;
    for (int tile = F.vcu; tile < M / 64; tile += F.G) {
        router_logits_tile(F, x3, tile, lg);
        if (F.wave == 0) {
            const int m = tile * 64 + lane; float l[8];
#pragma unroll
            for (int e = 0; e < 8; ++e) l[e] = lg[lane * 8 + e];
            int e0 = 0; float v0 = l[0];
#pragma unroll
            for (int e = 1; e < 8; ++e) if (l[e] > v0) { v0 = l[e]; e0 = e; }
            int e1 = -1; float v1 = -INFINITY;
#pragma unroll
            for (int e = 0; e < 8; ++e) if (e != e0 && l[e] > v1) { v1 = l[e]; e1 = e; }
            const float ex = __expf(v1 - v0), g0 = 1.f / (1.f + ex), g1 = ex * g0;
            *(GAS unsigned long long*)(topi + 2 * m) = (unsigned long long)(unsigned)e0 | ((unsigned long long)(unsigned)e1 << 32);
            *(GAS unsigned long long*)(topg + 2 * m) = (unsigned long long)__float_as_uint(g0) | ((unsigned long long)__float_as_uint(g1) << 32);
#pragma unroll
            for (int e = 0; e < 8; ++e) { const int cnt = __popcll(__ballot(e0 == e)) + __popcll(__ballot(e1 == e)); if (lane == e) histg[tile * 8 + e] = cnt; }
        }
        __syncthreads();
    }
}
__device__ __forceinline__ void phase_route_b(Frame& F) {
    LAS int* cnt = (LAS int*)(F.lds + RING_OFF);
    LAS int* offs = cnt + 2048;
    LAS int* tpos = cnt + 2048 + 64;
    const int* histg = (const int*)(F.ws + SM_HIST); const int* topi = (const int*)(F.ws + WS_TOPI); int* pos = (int*)(F.ws + WS_POS); int* meta = (int*)(F.ws + SM_META);
    const bf16* x3 = (const bf16*)F.out; bf16* xg = (bf16*)(F.ws + WS_XG);
    for (int i = F.tid; i < 2048; i += NTHREADS) cnt[i] = histg[i];
    __syncthreads();
    if (F.tid < 8) { int run = 0; for (int t = 0; t < 256; ++t) { const int c = cnt[t * 8 + F.tid]; cnt[t * 8 + F.tid] = run; run += c; } offs[16 + F.tid] = run; }
    __syncthreads();
    if (F.tid == 0) { int o = 0; for (int e = 0; e < 8; ++e) { offs[e] = o; o += (offs[16 + e] + 255) & ~255; } offs[8] = o; }
    __syncthreads();
    if (blockIdx.x == 0 && F.tid < 9) meta[F.tid] = offs[F.tid];
    for (int tile = F.vcu; tile < M / 64; tile += F.G) {
        if (F.wave == 0) { const int m = tile * 64 + F.lane; const int e0 = topi[2 * m], e1 = topi[2 * m + 1]; int p0 = 0, p1 = 0;
#pragma unroll
            for (int e = 0; e < 8; ++e) { const unsigned long long mk = __ballot(e0 == e || e1 == e); const int rank = __popcll(mk & ((1ull << F.lane) - 1ull)); const int base = offs[e] + cnt[tile * 8 + e];
                if (e0 == e) p0 = base + rank; if (e1 == e) p1 = base + rank; }
            pos[2 * m] = p0; pos[2 * m + 1] = p1; tpos[2 * F.lane] = p0; tpos[2 * F.lane + 1] = p1; }
        __syncthreads();
        { v4u ra[8][2];
#pragma unroll
            for (int q = 0; q < 8; ++q) { const int tk = F.wave * 8 + q; const GAS v4u* src = (const GAS v4u*)(x3 + (size_t)(tile * 64 + tk) * XRP) + F.lane; ra[q][0] = src[0]; ra[q][1] = src[64]; }
#pragma unroll
            for (int q = 0; q < 8; ++q) { const int tk = F.wave * 8 + q; float f[16]; float s = 0.f;
#pragma unroll
                for (int hq = 0; hq < 2; ++hq)
#pragma unroll
                    for (int e = 0; e < 4; ++e) { f[8 * hq + 2 * e] = bflo(ra[q][hq][e]); f[8 * hq + 2 * e + 1] = bfhi(ra[q][hq][e]); }
#pragma unroll
                for (int e = 0; e < 16; ++e) s += f[e] * f[e];
                const float rstd = 1.f / sqrtf(wave_sum(s) * (1.f / DM) + EPS);
                v4u w0, w1;
#pragma unroll
                for (int e = 0; e < 4; ++e) { w0[e] = pg8::cvt_pk_bf16(f[2 * e] * rstd, f[2 * e + 1] * rstd); w1[e] = pg8::cvt_pk_bf16(f[8 + 2 * e] * rstd, f[8 + 2 * e + 1] * rstd); }
#pragma unroll
                for (int sl = 0; sl < 2; ++sl) { GAS v4u* dst = (GAS v4u*)(xg + (size_t)tpos[2 * tk + sl] * DM) + F.lane; dst[0] = w0; dst[64] = w1; } } }
        __syncthreads();
    }
    if (blockIdx.x < 8) { const int e = blockIdx.x; const int r0 = offs[e] + offs[16 + e], r1 = offs[e + 1];
        for (int r = r0 + F.wave; r < r1; r += NWAVES) { GAS v4u* dst = (GAS v4u*)(xg + (size_t)r * DM) + F.lane; dst[0] = (v4u){0u, 0u, 0u, 0u}; dst[64] = (v4u){0u, 0u, 0u, 0u}; } }
}
__device__ __forceinline__ f32x4 moe_y_tail(const float* YT, int T, int P, int tix, int pos, int lane) {
    f32x4 a = (f32x4){0.f, 0.f, 0.f, 0.f};
    for (int p = 0; p < P; ++p) a = a + *(const GAS f32x4*)(YT + ((size_t)(p * T + tix) * 256 + (pos & 255)) * 256 + 4 * lane);
    return a;
}
__device__ __forceinline__ f32x4 bf4_to_f32(unsigned lo, unsigned hi) { return (f32x4){bflo(lo), bfhi(lo), bflo(hi), bfhi(hi)}; }
__device__ __forceinline__ void phase_combine(Frame& F) {
    typedef unsigned u32x2c __attribute__((ext_vector_type(2)));
    const int gw = F.vcu * NWAVES + F.wave, NGW = F.G * NWAVES, lane = F.lane;
    const bf16* Y = (const bf16*)(F.ws + WS_Y); const float* YT = (const float*)(F.ws + WS_YT); const int* pos = (const int*)(F.ws + WS_POS); const float* topg = (const float*)(F.ws + WS_TOPG);
    const int* meta = (const int*)(F.ws + SM_META); const int* tidx = meta + 16; const int T = __builtin_amdgcn_readfirstlane(meta[9]), P = __builtin_amdgcn_readfirstlane(meta[10]);
    for (int m0 = gw; m0 + NGW < M; m0 += 2 * NGW) {
        f32x4 xo[2][4]; u32x2c ya[2][4], yb[2][4]; float g0[2], g1[2]; int pp[2][2];
#pragma unroll
        for (int q = 0; q < 2; ++q) { const int m = m0 + q * NGW; pp[q][0] = __builtin_amdgcn_readfirstlane(pos[2 * m]); pp[q][1] = __builtin_amdgcn_readfirstlane(pos[2 * m + 1]); g0[q] = topg[2 * m]; g1[q] = topg[2 * m + 1];
            const GAS u32x2c* o = (const GAS u32x2c*)((const bf16*)F.out + (size_t)m * XRP) + lane; const GAS u32x2c* y0 = (const GAS u32x2c*)(Y + (size_t)pp[q][0] * DM) + lane; const GAS u32x2c* y1 = (const GAS u32x2c*)(Y + (size_t)pp[q][1] * DM) + lane;
#pragma unroll
            for (int j = 0; j < 4; ++j) { const u32x2c xw = o[64 * j]; xo[q][j] = bf4_to_f32(xw.x, xw.y); ya[q][j] = y0[64 * j]; yb[q][j] = y1[64 * j]; } }
        asm volatile("s_waitcnt vmcnt(0)" ::: "memory");
#pragma unroll
        for (int q = 0; q < 2; ++q) { GAS f32x4* o = (GAS f32x4*)(F.out + (size_t)(m0 + q * NGW) * DM) + lane;
#pragma unroll
            for (int j = 0; j < 4; ++j) { f32x4 a = bf4_to_f32(ya[q][j].x, ya[q][j].y), b = bf4_to_f32(yb[q][j].x, yb[q][j].y);
                if (T > 0) { const int t0 = __builtin_amdgcn_readfirstlane(tidx[(pp[q][0] >> 8) * 4 + j]), t1 = __builtin_amdgcn_readfirstlane(tidx[(pp[q][1] >> 8) * 4 + j]);
                    if (t0 >= 0) a = moe_y_tail(YT, T, P, t0, pp[q][0], lane); if (t1 >= 0) b = moe_y_tail(YT, T, P, t1, pp[q][1], lane); }
                o[64 * j] = xo[q][j] + g0[q] * a + g1[q] * b; } }
    }
}

__device__ __forceinline__ void phase_attn_naive(Frame& F, const Args& A, int it_lo, int it_hi) {
    LAS float* Ks = (LAS float*)(F.lds + RING_OFF); LAS float* Vs = Ks + 64 * 64;
    const bf16* QKV = (const bf16*)(F.ws + WS_QKV); bf16* O = (bf16*)(F.ws + WS_O); const int tid = F.tid, qi = tid >> 1, dh = tid & 1;
    for (int it = it_lo + F.vcu; it < it_hi; it += F.G) {
        const int grp = it >> 9, r = it & 511, b = r >> 8, h = grp * 8 + ((r >> 5) & 7), qb = r & 31;
        const int tq = qb * 256 + qi; const size_t row = (size_t)b * SEQ + tq;
        const bool win = h < 8; const int qcol = win ? 64 * h : 512 + 64 * (h - 8); const int kvh = win ? (h >> 2) : 2 + ((h - 8) >> 2); const int kcol = 1024 + 64 * kvh, vcol = 1280 + 64 * kvh;
        float q[64], o[32];
#pragma unroll
        for (int d = 0; d < 64; ++d) q[d] = bf2f(QKV[row * 1536 + qcol + d]);
#pragma unroll
        for (int d = 0; d < 32; ++d) o[d] = 0.f;
        float mx = -INFINITY, l = 0.f;
        const int t_lo = win ? (qb * 256 - 128 < 0 ? 0 : qb * 256 - 128) : 0, t_hi = win ? (qb * 256 + 384 > SEQ ? SEQ : qb * 256 + 384) : SEQ;
        for (int kt = t_lo; kt < t_hi; kt += 64) {
            __syncthreads();
            for (int i = tid; i < 64 * 64; i += NTHREADS) { const int rr = i >> 6, d = i & 63; const size_t kr = ((size_t)b * SEQ + kt + rr) * 1536; Ks[i] = bf2f(QKV[kr + kcol + d]); Vs[i] = bf2f(QKV[kr + vcol + d]); }
            __syncthreads();
            for (int j0 = 0; j0 < 64; j0 += 8) {
                float s[8]; float cm = -INFINITY;
#pragma unroll
                for (int jj = 0; jj < 8; ++jj) { float a = 0.f;
#pragma unroll
                    for (int d = 0; d < 64; ++d) a += q[d] * Ks[(j0 + jj) * 64 + d];
                    const int rel = tq - (kt + j0 + jj); if (win && (rel > 128 || rel < -128)) a = -INFINITY; s[jj] = a; cm = fmaxf(cm, a); }
                const float mn = fmaxf(mx, cm);
                if (mn == -INFINITY) continue;
                const float f = exp2f(mx - mn); l *= f;
#pragma unroll
                for (int d = 0; d < 32; ++d) o[d] *= f;
#pragma unroll
                for (int jj = 0; jj < 8; ++jj) { const float p = exp2f(s[jj] - mn); l += p;
#pragma unroll
                    for (int d = 0; d < 32; ++d) o[d] += p * Vs[(j0 + jj) * 64 + 32 * dh + d]; }
                mx = mn;
            }
        }
        if (win) l += exp2f(A.in[5][h] * 1.4426950408889634f - mx);
        const float rl = 1.f / l;
#pragma unroll
        for (int d = 0; d < 32; d += 2) *(unsigned*)(O + row * 1024 + 64 * h + 32 * dh + d) = pk2(o[d] * rl, o[d + 1] * rl);
        __syncthreads();
    }
}
__device__ __forceinline__ void phase_gdn_naive(Frame& F, int dlo, int dhi) {
    LAS float* ks = (LAS float*)(F.lds + RING_OFF);
    LAS float* qs = ks + 256;
    LAS float* part = qs + 256;
    LAS float* part2 = part + 1024;
    const int tid = F.tid, dv = tid & 127, qt = tid >> 7;
    const bf16* CQ = (const bf16*)(F.ws + WS_CQ); const bf16* CK = (const bf16*)(F.ws + WS_CK); const bf16* CV = (const bf16*)(F.ws + WS_CV);
    for (int it = dlo * 16 + F.vcu; it < dhi * 16; it += F.G) {
        const int dir = it >> 4, b = (it >> 3) & 1, h = it & 7;
        const float* G = (const float*)(F.ws + (dir ? WS_GB : WS_GF)); const float* BETA = (const float*)(F.ws + (dir ? WS_BB : WS_BF)); bf16* OUT = (bf16*)(F.ws + (dir ? WS_OB : WS_OF));
        float S[32];
#pragma unroll
        for (int i = 0; i < 32; ++i) S[i] = 0.f;
        for (int step = 0; step < SEQ; ++step) {
            const int t = dir ? SEQ - 1 - step : step; const size_t row = (size_t)b * SEQ + t; const int pb = step & 1;
            if (tid < 128) ks[pb * 128 + tid] = bf2f(CK[row * 1024 + h * 128 + tid]); else if (tid < 256) qs[pb * 128 + tid - 128] = bf2f(CQ[row * 1024 + h * 128 + tid - 128]);
            const float v = bf2f(CV[row * 1024 + h * 128 + dv]); const float eg = __expf(G[row * 8 + h]), beta = BETA[row * 8 + h];
            __syncthreads();
            float ps = 0.f;
#pragma unroll
            for (int i = 0; i < 32; ++i) { S[i] *= eg; ps += ks[pb * 128 + 32 * qt + i] * S[i]; }
            part[(pb * 4 + qt) * 128 + dv] = ps;
            __syncthreads();
            const float delta = beta * (v - ((part[(pb * 4 + 0) * 128 + dv] + part[(pb * 4 + 1) * 128 + dv]) + (part[(pb * 4 + 2) * 128 + dv] + part[(pb * 4 + 3) * 128 + dv])));
            float po = 0.f;
#pragma unroll
            for (int i = 0; i < 32; ++i) { S[i] += ks[pb * 128 + 32 * qt + i] * delta; po += qs[pb * 128 + 32 * qt + i] * S[i]; }
            part2[(pb * 4 + qt) * 128 + dv] = po;
            __syncthreads();
            if (qt == 0) OUT[row * 1024 + h * 128 + dv] = (bf16)f2bf((part2[(pb * 4 + 0) * 128 + dv] + part2[(pb * 4 + 1) * 128 + dv]) + (part2[(pb * 4 + 2) * 128 + dv] + part2[(pb * 4 + 3) * 128 + dv]));
        }
        __syncthreads();
    }
}

__global__ void __launch_bounds__(256) naive_attn(const bf16* __restrict__ QKV, const float* __restrict__ sink, bf16* __restrict__ O) {
    __shared__ float Ks[64][64]; __shared__ float Vs[64][64];
    const int b = blockIdx.z, h = blockIdx.y, qb = blockIdx.x, tid = threadIdx.x;
    const int tq = qb * 256 + tid; const size_t row = (size_t)b * SEQ + tq;
    const bool win = h < 8; const int qcol = win ? 64 * h : 512 + 64 * (h - 8); const int kvh = win ? (h >> 2) : 2 + ((h - 8) >> 2); const int kcol = 1024 + 64 * kvh, vcol = 1280 + 64 * kvh;
    float q[64], o[64];
#pragma unroll
    for (int d = 0; d < 64; ++d) { q[d] = bf2f(QKV[row * 1536 + qcol + d]); o[d] = 0.f; }
    float mx = -INFINITY, l = 0.f;
    const int t_lo = win ? (qb * 256 - 128 < 0 ? 0 : qb * 256 - 128) : 0, t_hi = win ? (qb * 256 + 384 > SEQ ? SEQ : qb * 256 + 384) : SEQ;
    for (int kt = t_lo; kt < t_hi; kt += 64) {
        __syncthreads();
        for (int i = tid; i < 64 * 64; i += 256) { const int r = i >> 6, d = i & 63; const size_t kr = ((size_t)b * SEQ + kt + r) * 1536; Ks[r][d] = bf2f(QKV[kr + kcol + d]); Vs[r][d] = bf2f(QKV[kr + vcol + d]); }
        __syncthreads();
        for (int j0 = 0; j0 < 64; j0 += 16) {
            float s[16]; float cm = -INFINITY;
#pragma unroll
            for (int jj = 0; jj < 16; ++jj) { float a = 0.f;
#pragma unroll
                for (int d = 0; d < 64; ++d) a += q[d] * Ks[j0 + jj][d];
                const int tk = kt + j0 + jj; const int rel = tq - tk; if (win && (rel > 128 || rel < -128)) a = -INFINITY; s[jj] = a; cm = fmaxf(cm, a); }
            const float mn = fmaxf(mx, cm);
            if (mn == -INFINITY) continue;
            const float f = exp2f(mx - mn); l *= f;
#pragma unroll
            for (int d = 0; d < 64; ++d) o[d] *= f;
#pragma unroll
            for (int jj = 0; jj < 16; ++jj) { const float p = exp2f(s[jj] - mn); l += p;
#pragma unroll
                for (int d = 0; d < 64; ++d) o[d] += p * Vs[j0 + jj][d]; }
            mx = mn;
        }
    }
    if (win) l += exp2f(sink[h] * 1.4426950408889634f - mx);
    const float rl = 1.f / l;
#pragma unroll
    for (int d = 0; d < 64; ++d) O[row * 1024 + 64 * h + d] = (bf16)f2bf(o[d] * rl);
}
__global__ void __launch_bounds__(256) naive_gdn(const bf16* __restrict__ CQ, const bf16* __restrict__ CK, const bf16* __restrict__ CV, const float* __restrict__ G, const float* __restrict__ BETA, bf16* __restrict__ OUT, int dir) {
    __shared__ float ks[2][128], qs[2][128], part[2][2][128], part2[2][2][128];
    const int b = blockIdx.x >> 3, h = blockIdx.x & 7, tid = threadIdx.x, dv = tid & 127, half = tid >> 7;
    float S[64];
#pragma unroll
    for (int i = 0; i < 64; ++i) S[i] = 0.f;
    for (int step = 0; step < SEQ; ++step) {
        const int t = dir ? SEQ - 1 - step : step; const size_t row = (size_t)b * SEQ + t; const int pb = step & 1;
        if (tid < 128) ks[pb][tid] = bf2f(CK[row * 1024 + h * 128 + tid]); else qs[pb][tid - 128] = bf2f(CQ[row * 1024 + h * 128 + tid - 128]);
        const float v = bf2f(CV[row * 1024 + h * 128 + dv]); const float eg = __expf(G[row * 8 + h]), beta = BETA[row * 8 + h];
        __syncthreads();
        float ps = 0.f;
#pragma unroll
        for (int i = 0; i < 64; ++i) { S[i] *= eg; ps += ks[pb][64 * half + i] * S[i]; }
        part[pb][half][dv] = ps;
        __syncthreads();
        const float delta = beta * (v - (part[pb][0][dv] + part[pb][1][dv]));
        float po = 0.f;
#pragma unroll
        for (int i = 0; i < 64; ++i) { S[i] += ks[pb][64 * half + i] * delta; po += qs[pb][64 * half + i] * S[i]; }
        part2[pb][half][dv] = po;
        __syncthreads();
        if (half == 0) OUT[row * 1024 + h * 128 + dv] = (bf16)f2bf(part2[pb][0][dv] + part2[pb][1][dv]);
    }
}


__device__ __forceinline__ int pi32(int m) { return (m & ~31) | (((m >> 2) & 1) << 4) | (((m >> 3) & 3) << 2) | (m & 3); }
__device__ __forceinline__ int pi32inv(int j) { return (j & ~31) | (((j >> 2) & 3) << 3) | (((j >> 4) & 1) << 2) | (j & 3); }
constexpr int mrow_off(int i) { return i == 0 ? 0 : 4 * ((((i - 1) >> 2) + 1) * (2 * ((i - 1) >> 2) + ((i - 1) & 3))); }
__device__ __forceinline__ int mrow_off_rt(int i) { const int T = i - 1, q = T >> 2, rem = T & 3; return i == 0 ? 0 : 4 * ((q + 1) * (2 * q + rem)); }
typedef float f32x16v __attribute__((ext_vector_type(16)));
constexpr int GDN_WLDS = 17408;
constexpr size_t GDN_SC_STRIDE = 192;

template <int I> struct InvRow {
    static __device__ __forceinline__ void run(float (&t)[64], const LAS float* Mp, int c) {
        InvRow<I - 1>::run(t, Mp, c);
        asm volatile("" ::: "memory");
        float a0 = (I == c) ? 1.f : 0.f, a1 = 0.f;
        const LAS f32x4* row = (const LAS f32x4*)(Mp + mrow_off(I));
#pragma unroll
        for (int jb = 0; jb < (I + 3) / 4; ++jb) { const f32x4 m = row[jb];
            if (4 * jb + 0 < I) a0 -= m.x * t[4 * jb + 0]; if (4 * jb + 1 < I) a1 -= m.y * t[4 * jb + 1]; if (4 * jb + 2 < I) a0 -= m.z * t[4 * jb + 2]; if (4 * jb + 3 < I) a1 -= m.w * t[4 * jb + 3]; }
        t[I] = a0 + a1;
    }
};
template <> struct InvRow<0> { static __device__ __forceinline__ void run(float (&t)[64], const LAS float*, int c) { t[0] = (c == 0) ? 1.f : 0.f; } };
template <int I> struct InvRowB {
    static __device__ __forceinline__ const LAS f32x4* rowp(const LAS float* Mp, int blk) { return (const LAS f32x4*)(Mp + (mrow_off(I) + ((-blk) & (mrow_off(32 + I) + 32 - mrow_off(I))))); }
    static __device__ __forceinline__ void run(float (&t)[32], const LAS float* Mp, int blk, int c, const f32x4 (&cur)[8]) {
        f32x4 nxt[8];
        if constexpr (I + 1 < 32) { const LAS f32x4* row = InvRowB<I + 1>::rowp(Mp, blk);
#pragma unroll
            for (int jb = 0; jb < (I + 1 + 3) / 4; ++jb) nxt[jb] = row[jb]; }
        asm volatile("" ::: "memory");
        float a0 = (I == c) ? 1.f : 0.f, a1 = 0.f;
#pragma unroll
        for (int jb = 0; jb < (I + 3) / 4; ++jb) { const f32x4 m = cur[jb];
            if (4 * jb + 0 < I) a0 -= m.x * t[4 * jb + 0]; if (4 * jb + 1 < I) a1 -= m.y * t[4 * jb + 1]; if (4 * jb + 2 < I) a0 -= m.z * t[4 * jb + 2]; if (4 * jb + 3 < I) a1 -= m.w * t[4 * jb + 3]; }
        t[I] = a0 + a1;
        if constexpr (I + 1 < 32) InvRowB<I + 1>::run(t, Mp, blk, c, nxt);
    }
};

__device__ __forceinline__ void phase_gdn_pre(Frame& F, int dir_lo, int dir_hi, int gw, int NGW, int n_lo, int n_hi, int single_item = -1, unsigned* war = nullptr) {
    const int ncnt = n_hi - n_lo, jend = single_item >= 0 ? 1 : (dir_hi - dir_lo) * 16 * ncnt; if (single_item >= 0) gw = 0;
    const bf16* CQ = (const bf16*)(F.ws + WS_CQ); const bf16* CK = (const bf16*)(F.ws + WS_CK); const bf16* CV = (const bf16*)(F.ws + WS_CV);
    for (int j = gw; j < jend; j += NGW) { const int item = single_item >= 0 ? single_item : (dir_lo * 16 + j / ncnt) * 128 + n_lo + j % ncnt;
        int lane = F.lane; asm volatile("" : "+v"(lane));
        LAS unsigned char* W = F.lds + (F.wave < 7 ? RING_OFF + F.wave * GDN_WLDS : 132 * 1024);
        LAS float* Mp = (LAS float*)W; LAS float* tgc = (LAS float*)(W + 8448); LAS float* tbe = tgc + 64;
        const int r32 = lane & 31, hh = lane >> 5;
        const int dir = item >> 11, b = (item >> 10) & 1, h = (item >> 7) & 7, n = item & 127;
        const int tbase = b * SEQ + (dir ? SEQ - 1 - 64 * n : 64 * n), tsgn = dir ? -1 : 1;
        const size_t grow = (size_t)(tbase + tsgn * lane) * 8 + h;
        const float g = ((const float*)(F.ws + (dir ? WS_GB : WS_GF)))[grow], be = ((const float*)(F.ws + (dir ? WS_BB : WS_BF)))[grow];
        float gc = g;
#pragma unroll
        for (int o = 1; o < 64; o <<= 1) { const float t = __shfl_up(gc, o); if (lane >= o) gc += t; }
        const float glast = __shfl(gc, 63);
        tgc[lane] = gc; tbe[lane] = be;
        float* sc = (float*)(F.ws + WS_GSC) + (size_t)item * GDN_SC_STRIDE;
        sc[lane] = __expf(gc); sc[64 + lane] = __expf(glast - gc); if (lane == 0) sc[128] = __expf(glast);
        asm volatile("" ::: "memory");
        const float gcj0 = tgc[r32], gcj1 = tgc[32 + r32];
        {
            f32x16v g00, g10, g11, s00, s10, s11;
#pragma unroll
            for (int r = 0; r < 16; ++r) { g00[r] = 0.f; g10[r] = 0.f; g11[r] = 0.f; s00[r] = 0.f; s10[r] = 0.f; s11[r] = 0.f; }
            {
                bf16x8 Kf[2][8];
#pragma unroll
                for (int I = 0; I < 2; ++I)
#pragma unroll
                    for (int ks = 0; ks < 8; ++ks) Kf[I][ks] = *(const GAS bf16x8*)(CK + (size_t)(tbase + tsgn * (32 * I + r32)) * 1024 + h * 128 + 16 * ks + 8 * hh);
                bf16x8 Qf[2][8];
#pragma unroll
                for (int I = 0; I < 2; ++I)
#pragma unroll
                    for (int ks = 0; ks < 8; ++ks) Qf[I][ks] = *(const GAS bf16x8*)(CQ + (size_t)(tbase + tsgn * (32 * I + r32)) * 1024 + h * 128 + 16 * ks + 8 * hh);
#pragma unroll
                for (int ks = 0; ks < 8; ++ks) { s00 = __builtin_amdgcn_mfma_f32_32x32x16_bf16(Qf[0][ks], Kf[0][ks], s00, 0, 0, 0); s10 = __builtin_amdgcn_mfma_f32_32x32x16_bf16(Qf[1][ks], Kf[0][ks], s10, 0, 0, 0);
                    s11 = __builtin_amdgcn_mfma_f32_32x32x16_bf16(Qf[1][ks], Kf[1][ks], s11, 0, 0, 0); }
#pragma unroll
                for (int ks = 0; ks < 8; ++ks) { g00 = __builtin_amdgcn_mfma_f32_32x32x16_bf16(Kf[0][ks], Kf[0][ks], g00, 0, 0, 0); g10 = __builtin_amdgcn_mfma_f32_32x32x16_bf16(Kf[1][ks], Kf[0][ks], g10, 0, 0, 0);
                    g11 = __builtin_amdgcn_mfma_f32_32x32x16_bf16(Kf[1][ks], Kf[1][ks], g11, 0, 0, 0); }
            }
            float gi0[16], gi1[16], bi0[16], bi1[16];
            { const LAS float* tg = tgc + 4 * hh; const LAS float* tb = tbe + 4 * hh;
#pragma unroll
                for (int r = 0; r < 16; ++r) { const int il0 = (r & 3) + 8 * (r >> 2); gi0[r] = tg[il0]; gi1[r] = tg[32 + il0]; bi0[r] = tb[il0]; bi1[r] = tb[32 + il0]; } }
            LAS bf16* img = (LAS bf16*)(W + 9216);
            const int m0 = pi32inv(r32), m1 = pi32inv(32 + r32);
            const int hhm = -hh;
            LAS float* Mr = Mp + r32; LAS bf16* im0 = img + hh * 256 + m0; LAS bf16* im1 = img + hh * 256 + m1;
#pragma unroll
            for (int r = 0; r < 16; ++r) { const int il0 = (r & 3) + 8 * (r >> 2);
                const int off0 = mrow_off(il0) + (hhm & (mrow_off(il0 + 4) - mrow_off(il0))), off1 = mrow_off(32 + il0) + (hhm & (mrow_off(36 + il0) - mrow_off(32 + il0)));
                const bool low = r32 < il0 + 4 * hh, lowe = r32 <= il0 + 4 * hh;
                const float d0 = __expf(gi0[r] - gcj0), d1 = __expf(gi1[r] - gcj0), d2 = __expf(gi1[r] - gcj1);
                if (low) Mr[off0] = bi0[r] * g00[r] * d0;
                Mr[off1] = bi1[r] * g10[r] * d1;
                if (low) Mr[off1 + 32] = bi1[r] * g11[r] * d2;
                im0[il0 * 64] = (bf16)f2bf(lowe ? s00[r] * d0 : 0.f); im1[il0 * 64] = (bf16)0;
                im0[(32 + il0) * 64] = (bf16)f2bf(s10[r] * d1); im1[(32 + il0) * 64] = (bf16)f2bf(lowe ? s11[r] * d2 : 0.f); }
            asm volatile("s_waitcnt lgkmcnt(0)" ::: "memory");
            if (war) { if (lane == 0) { unsigned sp_ = 0; while (xb_ld(war) < (unsigned)F.G && ++sp_ < (1u << 22)) __builtin_amdgcn_s_sleep(2); } asm volatile("" ::: "memory"); }
            GAS v4u* qkm = (GAS v4u*)((bf16*)(F.ws + WS_GQKM) + (size_t)item * 4096) + lane;
#pragma unroll
            for (int q = 0; q < 8; ++q) qkm[64 * q] = *(const LAS v4u*)(W + 9216 + (lane + 64 * q) * 16);
        }
        asm volatile("s_waitcnt lgkmcnt(0)" ::: "memory");
        asm volatile("" ::: "memory");
        const int blk = lane >> 5, cc = lane & 31;
        float t[32];
        { f32x4 r0[8]; InvRowB<0>::run(t, Mp, blk, cc, r0); }
        f32x16v Q2;
        {
            LAS float* T11s = (LAS float*)(W + 9216);
            asm volatile("s_waitcnt lgkmcnt(0)" ::: "memory");
            if (blk) {
#pragma unroll
                for (int i = 0; i < 32; ++i) T11s[i * 36 + cc] = t[i]; }
            const LAS f32x4* m10 = (const LAS f32x4*)(Mp + mrow_off_rt(32 + cc) + 16 * blk);
            f32x4 a4[4];
#pragma unroll
            for (int q = 0; q < 4; ++q) a4[q] = m10[q];
            f32x16v P;
#pragma unroll
            for (int r = 0; r < 16; ++r) { P[r] = 0.f; Q2[r] = 0.f; }
#pragma unroll
            for (int s_ = 0; s_ < 16; ++s_) { const float up = __shfl(t[16 + s_], cc); const float bv = blk ? up : t[s_];
                P = __builtin_amdgcn_mfma_f32_32x32x2f32(a4[s_ >> 2][s_ & 3], bv, P, 0, 0, 0); }
            asm volatile("" ::: "memory");
            const LAS f32x4* t11r = (const LAS f32x4*)(T11s + cc * 36 + 4 * blk);
            f32x4 b4[4];
#pragma unroll
            for (int q = 0; q < 4; ++q) b4[q] = t11r[2 * q];
#pragma unroll
            for (int s_ = 0; s_ < 16; ++s_) Q2 = __builtin_amdgcn_mfma_f32_32x32x2f32(b4[s_ >> 2][s_ & 3], P[s_], Q2, 0, 0, 0);
            asm volatile("s_waitcnt lgkmcnt(0)" ::: "memory");
        }
        asm volatile("" ::: "memory");
        { LAS bf16* img = (LAS bf16*)(W + 9216);
            const int pc = pi32inv(lane);
#pragma unroll
            for (int i = 0; i < 32; ++i) img[(32 * blk + i) * 64 + pc] = (bf16)f2bf(t[i] * be);
            const float bec = tbe[cc]; const int pcc = pi32inv(cc);
#pragma unroll
            for (int r = 0; r < 16; ++r) { const int il = (r & 3) + 8 * (r >> 2) + 4 * blk; img[(32 + il) * 64 + pcc] = (bf16)f2bf(-Q2[r] * bec); }
#pragma unroll
            for (int q = 0; q < 2; ++q) { const int p_ = lane + 64 * q; *(LAS v4u*)(W + 9216 + (p_ >> 2) * 128 + 64 + (p_ & 3) * 16) = (v4u){0u, 0u, 0u, 0u}; }
            asm volatile("s_waitcnt lgkmcnt(0)" ::: "memory");
            if (war) { if (lane == 0) { unsigned sp_ = 0; while (xb_ld(war) < (unsigned)F.G && ++sp_ < (1u << 22)) __builtin_amdgcn_s_sleep(2); } asm volatile("" ::: "memory"); }
            GAS v4u* tp = (GAS v4u*)((bf16*)(F.ws + WS_GTP) + (size_t)item * 4096) + lane;
#pragma unroll
            for (int q = 0; q < 8; ++q) tp[64 * q] = *(const LAS v4u*)(W + 9216 + (lane + 64 * q) * 16); }
        asm volatile("s_waitcnt lgkmcnt(0)" ::: "memory");
    }
}

typedef float f32x4v __attribute__((ext_vector_type(4)));
typedef short s16x4t __attribute__((ext_vector_type(4))); typedef short v4i16t __attribute__((ext_vector_type(4)));
__device__ __forceinline__ bf16x8 pack_tiles(const f32x4v& a, const f32x4v& b) {
    v4u p; p.x = pg8::cvt_pk_bf16(a[0], a[1]); p.y = pg8::cvt_pk_bf16(a[2], a[3]); p.z = pg8::cvt_pk_bf16(b[0], b[1]); p.w = pg8::cvt_pk_bf16(b[2], b[3]); return __builtin_bit_cast(bf16x8, p); }
constexpr int GDN_XOFF = 132 * 1024, GDN_XBUF = 5120;
constexpr int GDN_EXOFF = 142 * 1024;
constexpr int GDN_FLAGOFF = GDN_EXOFF + 12288;
constexpr int GDN_WARM = 5;
#ifndef GDN_OUT_SLEEP
#define GDN_OUT_SLEEP 4
#endif
constexpr int GDN_NSPLIT = 64;
constexpr int GDN_OSTOFF = 155 * 1024;
__device__ __forceinline__ void phase_gdn_scan(Frame& F, int dir_lo, int dir_hi) {
    if (F.vcu >= 128) return;
    const int lane = F.lane, wave = F.wave, seq = F.vcu >> 2, qtr = F.vcu & 3;
    const int dir = seq >> 4, b = (seq >> 3) & 1, h = seq & 7;
    if (dir < dir_lo || dir >= dir_hi) return;
    const int item0 = seq * 128;
    LAS unsigned char* L = F.lds + RING_OFF; LAS unsigned char* LX = F.lds + GDN_XOFF;
    const bf16* CQ = (const bf16*)(F.ws + WS_CQ); const bf16* CK = (const bf16*)(F.ws + WS_CK); const bf16* CVg = (const bf16*)(F.ws + WS_CV);
    const bf16* TPg = (const bf16*)(F.ws + WS_GTP); const bf16* QKMg = (const bf16*)(F.ws + WS_GQKM);
    const float* SC = (const float*)(F.ws + WS_GSC); bf16* OUT = (bf16*)(F.ws + (dir ? WS_OB : WS_OF));
    const int tsgn = dir ? -1 : 1;
    const int role = wave < 2 ? 0 : (wave < 4 ? 1 : 2);
    const int pr = wave & 1;
    const int c = lane & 15, qd = lane >> 4, dv0 = 32 * qtr + 16 * pr;
    unsigned long long sp[14]; int npc = 0;
    if (role == 2) {
#pragma unroll
        for (int e = 0; e < 14; ++e) { const int d = (wave - 4) + 4 * e; sp[e] = 0ull;
            if (d < 53) { npc = e + 1; const int tb_ = b * SEQ + (dir ? SEQ - 1 : 0); const char* src_;
                if (d < 32) { const int row = 4 * (d & 15) + (lane >> 4), chunk = (lane & 15) ^ (row & 15); src_ = (const char*)((d < 16 ? CK : CQ) + (size_t)(tb_ + tsgn * row) * 1024 + h * 128 + 8 * chunk); }
                else if (d < 48) { const int dd = d < 40 ? d - 32 : d - 40; const int R = 4 * dd + (lane >> 4), c16 = (lane & 15) ^ (R & 15), row = 2 * R + (c16 >> 3), ch = c16 & 7;
                    const bf16* mb = (d < 40 ? TPg : QKMg) + (size_t)item0 * 4096; src_ = (const char*)(mb + row * 64 + ch * 8); }
                else if (d < 52) { const int row = 16 * (d - 48) + (lane >> 2); src_ = (const char*)(CVg + (size_t)(tb_ + tsgn * row) * 1024 + h * 128 + 32 * qtr + 8 * (lane & 3)); }
                else src_ = (const char*)(SC + (size_t)item0 * GDN_SC_STRIDE) + lane * 16;
                sp[e] = (unsigned long long)(uintptr_t)src_; } }
    }
    const unsigned ldsbase = (unsigned)(uintptr_t)F.lds;
#define GDN_STAGE(buf_) do { unsigned wb_ = ldsbase + (unsigned)(wave - 4) * 1024u; asm volatile("" : "+s"(wb_)); long long skq_ = (long long)tsgn * 131072; asm volatile("" : "+s"(skq_)); \
        _Pragma("unroll") for (int e = 0; e < 14; ++e) if (e < 13 || wave == 4) { \
              \
            const unsigned dst_ = wb_ + (e < 12 ? (unsigned)(RING_OFF + 4 * e * 1024 + (buf_) * 65536) : (unsigned)(GDN_XOFF + (4 * e - 48) * 1024 + (buf_) * GDN_XBUF)); \
            asm volatile("s_mov_b32 m0, %1\n\ts_nop 0\n\tglobal_load_lds_dwordx4 %0, off" : : "v"(sp[e]), "s"(dst_) : "memory", "m0"); \
            sp[e] += (unsigned long long)((e < 8 || e == 12) ? skq_ : (e < 12 ? 8192ll : (long long)(GDN_SC_STRIDE * 4))); } } while (0)
    LAS unsigned char* exS = F.lds + GDN_EXOFF + pr * 6144; LAS unsigned char* exV = exS + 4096;
    LAS unsigned char* exS1 = F.lds + RING_OFF + 49152 + pr * 4096;
    volatile LAS int* fV = (volatile LAS int*)(F.lds + GDN_FLAGOFF + pr * 64); volatile LAS int* fS = fV + 8;
    if (F.tid < 64) ((LAS int*)(F.lds + GDN_FLAGOFF))[F.tid] = 0;
    f32x4v S[8];
#pragma unroll
    for (int i = 0; i < 8; ++i) S[i] = (f32x4v){0.f, 0.f, 0.f, 0.f};
    bf16x8 Sb[4];
#pragma unroll
    for (int ks = 0; ks < 4; ++ks) Sb[ks] = (bf16x8){0, 0, 0, 0, 0, 0, 0, 0};
    if (role == 0) {
#pragma unroll
        for (int ks = 0; ks < 4; ++ks) *(LAS bf16x8*)(exS + ks * 1024 + lane * 16) = Sb[ks]; }
    if (role == 2) GDN_STAGE(0);
    asm volatile("s_waitcnt vmcnt(0) lgkmcnt(0)" ::: "memory"); __builtin_amdgcn_s_barrier(); asm volatile("" ::: "memory");
    int o256[4], o128[2][2];
#pragma unroll
    for (int ks = 0; ks < 4; ++ks) o256[ks] = c * 256 + (((4 * ks + qd) ^ c) << 4);
#pragma unroll
    for (int mp = 0; mp < 2; ++mp)
#pragma unroll
        for (int ks = 0; ks < 2; ++ks) o128[mp][ks] = (c >> 1) * 256 + (((((c & 1) << 3) + 4 * ks + qd) ^ ((8 * mp + (c >> 1)) & 15)) << 4);
    const int osc = 4096 + 16 * qd;
    const int tq = (lane >> 2) & 3, tp = lane & 3, rr = 4 * qd + tq;
    const int ovt = rr * 64 + 32 * pr + 8 * tp;
    int otr[8];
#pragma unroll
    for (int dt = 0; dt < 8; ++dt) otr[dt] = rr * 256 + ((((4 * (dt >> 1) + tp) ^ rr) & 15) << 4) + ((dt & 1) << 3);
#define FRAG256(reg_, mt_, ks_) (*(const LAS bf16x8*)(Lb + o256[ks_] + ((reg_) + 4096 * (mt_))))
#define FRAG128(reg_, mt_, ks_) (*(const LAS bf16x8*)(Lb + o128[(mt_) & 1][ks_] + ((reg_) + 2048 * (mt_))))
#define MF16(a_, b_, c_) __builtin_amdgcn_mfma_f32_16x16x32_bf16((a_), (b_), (c_), 0, 0, 0)
#if defined(GDN_EXP_STAGE)
    for (int n = 0; n < 128; ++n) {
        if (role == 2) {
            { int hw_ = wave - 4; asm volatile("" : "+s"(hw_)); _Pragma("unroll") for (int e = 0; e < 14; ++e) if (e < npc) { const int d_ = hw_ + 4 * e;
                const unsigned dst_ = ldsbase + (d_ < 48 ? (unsigned)(RING_OFF + d_ * 1024 + 65536) : (unsigned)(GDN_XOFF + (d_ - 48) * 1024 + GDN_XBUF));
                const int st_ = d_ < 32 ? tsgn * 131072 : (d_ < 48 ? 8192 : (d_ < 52 ? tsgn * 131072 : (int)(GDN_SC_STRIDE * 4))); unsigned keep_;
                asm volatile("s_mov_b32 %0, m0\n\ts_mov_b32 m0, %2\n\ts_nop 0\n\tglobal_load_lds_dwordx4 %1, off\n\ts_mov_b32 m0, %0" : "=&s"(keep_) : "v"(sp[e]), "s"(dst_) : "memory");
                sp[e] += (unsigned long long)(long long)((n & 1) ? -st_ : st_); } }
            asm volatile("s_waitcnt vmcnt(0)" ::: "memory");
        }
        asm volatile("s_waitcnt lgkmcnt(0)" ::: "memory"); __builtin_amdgcn_s_barrier(); asm volatile("" ::: "memory");
    }
#endif
    for (int n = 0; n < 128; ++n) {
        const LAS unsigned char* Lb = L + (n & 1) * 65536; const LAS unsigned char* Xp = LX + (n & 1) * GDN_XBUF;
        if (role == 2) {
#ifdef GDN_STAGE_SLEEP
            __builtin_amdgcn_s_sleep(GDN_STAGE_SLEEP);
#endif
            if (n + 1 < 128) GDN_STAGE((n + 1) & 1);
            const int mw = n + GDN_WARM;
            if (false && wave == 4 && mw < 128) { const int item_ = item0 + mw; const int tb_ = b * SEQ + (dir ? SEQ - 1 - 64 * mw : 64 * mw); const char *p0, *p1;
                if (qtr == 0) { p0 = (const char*)(CK + (size_t)(tb_ + tsgn * lane) * 1024 + h * 128); p1 = p0 + 128; }
                else if (qtr == 1) { p0 = (const char*)(CQ + (size_t)(tb_ + tsgn * lane) * 1024 + h * 128); p1 = p0 + 128; }
                else if (qtr == 2) { p0 = (const char*)(TPg + (size_t)item_ * 4096) + lane * 128; p1 = p0; }
                else { p0 = (const char*)(TPg + (size_t)item_ * 4096) + lane * 128; p1 = (const char*)(QKMg + (size_t)item_ * 4096) + lane * 128; }
                const char* p2 = (const char*)(SC + (size_t)item_ * GDN_SC_STRIDE) + (lane & 7) * 128;
                LAS unsigned* dmy = (LAS unsigned*)(F.lds + GDN_FLAGOFF + 256);
                __builtin_amdgcn_global_load_lds((const unsigned*)p0, dmy, 4, 0, 0); __builtin_amdgcn_global_load_lds((const unsigned*)p1, dmy, 4, 0, 0); __builtin_amdgcn_global_load_lds((const unsigned*)p2, dmy, 4, 0, 0);
                asm volatile("s_waitcnt vmcnt(3)" ::: "memory");
            } else {
                if (n + 2 == GDN_NSPLIT && wave == 7 && F.G > 128) { if (lane == 0) { unsigned* cw = (unsigned*)(F.ctl + CW_P10B); const unsigned need = (unsigned)(F.G - 128); unsigned sp_ = 0;
                        while (xb_ld(cw) < need && ++sp_ < (1u << 24)) __builtin_amdgcn_s_sleep(2); }
                    __builtin_amdgcn_fence(__ATOMIC_ACQUIRE, "agent"); }
                asm volatile("s_waitcnt vmcnt(0)" ::: "memory"); }
        } else if (role == 0) {
            __builtin_amdgcn_s_setprio(2);
#ifdef GDN_CHAIN_SLEEP
            __builtin_amdgcn_s_sleep(GDN_CHAIN_SLEEP);
#endif
            bf16x8 Kfr[4][4];
#pragma unroll
            for (int mt = 0; mt < 4; ++mt)
#pragma unroll
                for (int ks = 0; ks < 4; ++ks) Kfr[mt][ks] = FRAG256(0, mt, ks);
            bf16x8 TPf[4][2];
#pragma unroll
            for (int mt = 0; mt < 4; ++mt)
#pragma unroll
                for (int ks = 0; ks < 2; ++ks) TPf[mt][ks] = FRAG128(32768, mt, ks);
            bf16x8 KTf[8][2];
#pragma unroll
            for (int dt = 0; dt < 8; ++dt)
#pragma unroll
                for (int ks = 0; ks < 2; ++ks) { const s16x4t lo = __builtin_bit_cast(s16x4t, __builtin_amdgcn_ds_read_tr16_b64_v4i16((LAS v4i16t*)(Lb + otr[dt] + 256 * (32 * ks)))), hi = __builtin_bit_cast(s16x4t, __builtin_amdgcn_ds_read_tr16_b64_v4i16((LAS v4i16t*)(Lb + otr[dt] + 256 * (32 * ks + 16))));
                    KTf[dt][ks] = (bf16x8){lo[0], lo[1], lo[2], lo[3], hi[0], hi[1], hi[2], hi[3]}; }
            unsigned long long vt[4]; f32x4v eg[4], ek[4];
#pragma unroll
            for (int mt = 0; mt < 4; ++mt) { vt[mt] = __builtin_bit_cast(unsigned long long, __builtin_amdgcn_ds_read_tr16_b64_v4i16((LAS v4i16t*)(Xp + ovt + 1024 * mt))); eg[mt] = *(const LAS f32x4v*)(Xp + osc + 64 * mt); ek[mt] = *(const LAS f32x4v*)(Xp + osc + 256 + 64 * mt); }
            const float gam = *(const LAS float*)(Xp + 4096 + 512);
            f32x4v X[4];
#pragma unroll
            for (int mt = 0; mt < 4; ++mt) { f32x4v a = (f32x4v){0.f, 0.f, 0.f, 0.f};
#pragma unroll
                for (int ks = 0; ks < 4; ++ks) a = MF16(Kfr[mt][ks], Sb[ks], a);
                const unsigned lo = (unsigned)vt[mt], hi = (unsigned)(vt[mt] >> 32);
                X[mt] = (f32x4v){bflo(lo), bfhi(lo), bflo(hi), bfhi(hi)} - eg[mt] * a; }
            bf16x8 Xb[2]; Xb[0] = pack_tiles(X[0], X[1]); Xb[1] = pack_tiles(X[2], X[3]);
            f32x4v VN[4];
#pragma unroll
            for (int mt = 0; mt < 4; ++mt) { f32x4v a = (f32x4v){0.f, 0.f, 0.f, 0.f};
#pragma unroll
                for (int ks = 0; ks < 2; ++ks) a = MF16(TPf[mt][ks], Xb[ks], a);
                VN[mt] = a; }
            bf16x8 VNb[2], VSb[2]; VNb[0] = pack_tiles(VN[0], VN[1]); VNb[1] = pack_tiles(VN[2], VN[3]);
            *(LAS bf16x8*)(exV + lane * 16) = VNb[0]; *(LAS bf16x8*)(exV + 1024 + lane * 16) = VNb[1];
            asm volatile("" ::: "memory");
            if (lane == 0) *fV = n + 1;
            { const f32x4v s0 = VN[0] * ek[0], s1 = VN[1] * ek[1], s2 = VN[2] * ek[2], s3 = VN[3] * ek[3]; VSb[0] = pack_tiles(s0, s1); VSb[1] = pack_tiles(s2, s3); }
#pragma unroll
            for (int dt = 0; dt < 8; ++dt) { f32x4v a = S[dt] * gam;
#pragma unroll
                for (int ks = 0; ks < 2; ++ks) a = MF16(KTf[dt][ks], VSb[ks], a);
                S[dt] = a; }
#pragma unroll
            for (int ks = 0; ks < 4; ++ks) Sb[ks] = pack_tiles(S[2 * ks], S[2 * ks + 1]);
#pragma unroll
            for (int ks = 0; ks < 4; ++ks) *(LAS bf16x8*)(((n + 1) & 1 ? exS1 : exS) + ks * 1024 + lane * 16) = Sb[ks];
        } else {
            __builtin_amdgcn_s_setprio(1);
            bf16x8 So[4];
#pragma unroll
            for (int ks = 0; ks < 4; ++ks) So[ks] = *(const LAS bf16x8*)((n & 1 ? exS1 : exS) + ks * 1024 + lane * 16);
            float egr[4];
#pragma unroll
            for (int mt = 0; mt < 4; ++mt) egr[mt] = *(const LAS float*)(Xp + 4096 + (16 * mt + c) * 4);
            bf16x8 Qfr[4][4];
#pragma unroll
            for (int mt = 0; mt < 4; ++mt)
#pragma unroll
                for (int ks = 0; ks < 4; ++ks) Qfr[mt][ks] = FRAG256(16384, mt, ks);
            asm volatile("s_waitcnt lgkmcnt(0)" ::: "memory");
            f32x4v O[4];
#pragma unroll
            for (int mt = 0; mt < 4; ++mt) { f32x4v a = (f32x4v){0.f, 0.f, 0.f, 0.f};
#pragma unroll
                for (int ks = 0; ks < 4; ++ks) a = MF16(So[ks], Qfr[mt][ks], a);
                O[mt] = a * egr[mt]; }
            bf16x8 QKf[4][2];
#pragma unroll
            for (int mt = 0; mt < 4; ++mt)
#pragma unroll
                for (int ks = 0; ks < 2; ++ks) QKf[mt][ks] = FRAG128(40960, mt, ks);
            asm volatile("" ::: "memory"); { int guard = 0; while (*fV < n + 1 && ++guard < (1 << 22)) { } } asm volatile("s_waitcnt lgkmcnt(0)" ::: "memory");
            const bf16x8 V0 = *(const LAS bf16x8*)(exV + lane * 16), V1 = *(const LAS bf16x8*)(exV + 1024 + lane * 16);
            const int tb = b * SEQ + (dir ? SEQ - 1 - 64 * n : 64 * n);
            typedef unsigned u32x2s __attribute__((ext_vector_type(2)));
#pragma unroll
            for (int mt = 0; mt < 4; ++mt) { f32x4v a = MF16(V0, QKf[mt][0], O[mt]); a = MF16(V1, QKf[mt][1], a);
                u32x2s w; w.x = pg8::cvt_pk_bf16(a[0], a[1]); w.y = pg8::cvt_pk_bf16(a[2], a[3]);
                *(GAS u32x2s*)(OUT + (size_t)(tb + tsgn * (16 * mt + c)) * 1024 + h * 128 + dv0 + 4 * qd) = w; }
        }
        asm volatile("s_waitcnt lgkmcnt(0)" ::: "memory"); __builtin_amdgcn_s_barrier(); asm volatile("" ::: "memory");
    }
    __builtin_amdgcn_s_setprio(0);
    asm volatile("s_waitcnt vmcnt(0)" ::: "memory");
#undef GDN_STAGE
#undef FRAG256
#undef FRAG128
#undef MF16
}

constexpr int NPHASE = 19;
#ifndef PROBE_MASK
#define PROBE_MASK 0u
#endif
#ifndef GDN_DLO
#define GDN_DLO 0
#define GDN_DHI 2
#endif
#ifndef ATT_SEL
#define ATT_SEL 3
#endif
__global__ void __launch_bounds__(NTHREADS, 2) mega(Args args) {
    extern __shared__ __attribute__((aligned(16))) unsigned char lds[];
    Frame F;
    F.lds = (LAS unsigned char*)lds; F.MISC = (volatile LAS unsigned*)(F.lds + MISC_OFF);
    F.tid = threadIdx.x; F.lane = F.tid & 63; F.wave = __builtin_amdgcn_readfirstlane(F.tid >> 6);
    F.G = gridDim.x; { const int bx = blockIdx.x; F.vcu = (F.G % 8 == 0) ? (bx % 8) * (F.G / 8) + bx / 8 : bx; }
    F.ws = args.ws; F.out = args.out; F.ctl = (gu32*)(args.ws + WS_CTL);
    for (int u = F.tid; u < (LDS_BYTES - LDSCTL_OFF) / 4; u += NTHREADS) ((LAS unsigned*)(F.lds + LDSCTL_OFF))[u] = 0u;
    __syncthreads();
    XcdBarrier bar; bar.bar = (unsigned*)(F.ctl + CW_BAR); bar.x = 0; bar.st = nullptr;
    if (args.use_bar) bar = xcd_barrier_post((unsigned*)(F.ctl + CW_BAR), F.MISC + 8);
    const int lo = args.ph_lo, hi = args.ph_hi;
#define IN(k) (lo <= (k) && (k) < hi)
#define PB GAS unsigned char* wsg_ = (GAS unsigned char*)args.ws; GAS float* outg_ = (GAS float*)args.out; asm volatile("" : "+s"(wsg_), "+s"(outg_)); unsigned char* ws = (unsigned char*)wsg_; float* outp = (float*)outg_; F.ws = ws; F.out = outp;     { int t_ = threadIdx.x; asm volatile("" : "+v"(t_)); F.tid = t_; F.lane = t_ & 63; F.wave = __builtin_amdgcn_readfirstlane(t_ >> 6); }
#define REP(k) for (int rp_ = 0; rp_ < (((PROBE_MASK >> (k)) & 1) ? 2 : 1); ++rp_)
#define REPBAR(k) if (((PROBE_MASK >> (k)) & 1) && rp_ == 0) xcd_barrier(bar);
#define SEAM(k) do { if (IN(k) && IN((k) + 1)) xcd_barrier(bar); } while (0)
    if (IN(0)) REP(0) { PB p0_prologue(F, args); REPBAR(0) } SEAM(0);
    if (IN(1)) REP(1) { PB asm volatile(".fill 22, 4, 0xBF800000" ::: "memory");     pg8::Gemm g{(const bf16*)(ws + WS_XN), (const bf16*)(ws + WS_W_ABIN), M, AB_IN, DM, 0}; pg8::StaticOrder S; S.init(M, AB_IN, F.G, (int)blockIdx.x, DM);
        const float* tab1 = (const float*)(ws + WS_TAB);
        pg8::EpiQKV E{(bf16*)(ws + WS_QKV), (const float*)(ws + SM_GAINS), tab1, QSCALE, EPS};
        pg8::gemm_phase<pg8::EpiQKV, pg8::StaticOrder, PG8_ALIGN, PG8_SP2>(F.lds + RING_OFF, g, S, E);
        { const int nu2 = 384 - F.G;     if ((int)blockIdx.x >= nu2 && nu2 >= 0 && nu2 < F.G) p1_deferred(F, args, ((int)blockIdx.x - nu2) * NWAVES + F.wave, (F.G - nu2) * NWAVES); else if (nu2 < 0 || nu2 >= F.G) p1_deferred(F, args, (int)blockIdx.x * NWAVES + F.wave, F.G * NWAVES); }
        REPBAR(1) } SEAM(1);
    if (IN(2)) REP(2) { PB attn_body::attn_phase<8>((char*)lds + RING_OFF, (const attn_body::bf16*)(ws + WS_QKV), (attn_body::bf16*)(ws + WS_O), args.in[5], F.vcu, F.G, ATT_SEL); if (ATT_SEL != 3) { __syncthreads(); phase_attn_naive(F, args, (ATT_SEL & 2) ? 512 : 0, (ATT_SEL & 1) ? 512 : 1024); } REPBAR(2) } SEAM(2);
    if (IN(3)) REP(3) { PB pg8::Gemm g{(const bf16*)(ws + WS_O), (const bf16*)(ws + WS_W_ABOUT), M, DM, DM, 0}; pg8::StaticOrder S; S.init(M, DM, F.G, (int)blockIdx.x, DM);
        pg8::EpiResBf16T<true> E{args.in[0], DM, nullptr, (bf16*)outp, XRP};
        pg8::gemm_phase<pg8::EpiResBf16T<true>, pg8::StaticOrder, PG8_ALIGN, PG8_SP2>(F.lds + RING_OFF, g, S, E); REPBAR(3) } SEAM(3);
    if (IN(4)) REP(4) { PB phase_rms(F, (const bf16*)outp, (bf16*)(ws + WS_XN)); REPBAR(4) } SEAM(4);
    if (IN(5)) REP(5) { PB pg8::Gemm g{(const bf16*)(ws + WS_XN), (const bf16*)(ws + WS_W_FGU), M, 2 * DFF, DM, 0}; pg8::StaticOrder S; S.init(M, 2 * DFF, F.G, (int)blockIdx.x, DM);
        pg8::EpiSwiGLU E{(bf16*)(ws + WS_ACT), DFF, nullptr, EPS};
        pg8::gemm_phase<pg8::EpiSwiGLU, pg8::StaticOrder, PG8_ALIGN, PG8_SP2>(F.lds + RING_OFF, g, S, E); REPBAR(5) } SEAM(5);
    if (IN(6)) REP(6) { PB pg8::Gemm g{(const bf16*)(ws + WS_ACT), (const bf16*)(ws + WS_W_FD), M, DM, DFF, 0}; pg8::StaticOrder S; S.init(M, DM, F.G, (int)blockIdx.x, DFF);
        pg8::EpiResBf16T<false> E{nullptr, 0, (const bf16*)outp, (bf16*)outp, XRP};
        pg8::gemm_phase<pg8::EpiResBf16T<false>, pg8::StaticOrder, PG8_ALIGN, PG8_SP2>(F.lds + RING_OFF, g, S, E); REPBAR(6) } SEAM(6);
    if (IN(7)) REP(7) { PB phase_rms(F, (const bf16*)outp, (bf16*)(ws + WS_XN)); phase_gates(F, (const bf16*)outp, (float*)(ws + WS_GATES)); REPBAR(7) } SEAM(7);
    if (IN(8)) REP(8) { PB pg8::Gemm g{(const bf16*)(ws + WS_XN), (const bf16*)(ws + WS_W_CIN), M, 3072, DM, 0}; pg8::StaticOrder S; S.init(M, 3072, F.G, (int)blockIdx.x, DM);
        pg8::EpiBf16<0> E{(bf16*)(ws + WS_PROJ), 1024, nullptr, 1024, (size_t)M * 1024, 1.f};
        pg8::gemm_phase<pg8::EpiBf16<0>, pg8::StaticOrder, PG8_ALIGN, PG8_SP2>(F.lds + RING_OFF, g, S, E); REPBAR(8) } SEAM(8);
    const bool p9_fused = (F.G == 256) && IN(9) && IN(10);
    if (IN(9)) REP(9) { PB phase_conv(F, args, p9_fused);
        if (p9_fused) { asm volatile("s_waitcnt vmcnt(0)" ::: "memory"); __syncthreads();
            if (F.tid == 0) (void)xb_add((unsigned*)(F.ctl + CW_CONV), 1u);
            const int b_ = F.vcu >> 7, c_ = F.vcu & 127, dir_ = c_ >> 6, n_ = dir_ ? 127 - c_ : c_;
            phase_gdn_pre(F, 0, 2, 0, 1, 0, GDN_NSPLIT, ((dir_ * 2 + b_) * 8 + F.wave) * 128 + n_, (unsigned*)(F.ctl + CW_CONV)); }
        REPBAR(9) } if (!p9_fused) SEAM(9);
    if (IN(10)) REP(10) { PB if (!p9_fused) phase_gdn_pre(F, GDN_DLO, GDN_DHI, F.vcu * NWAVES + F.wave, F.G * NWAVES, 0, F.G > 128 ? GDN_NSPLIT : 128); REPBAR(10) } SEAM(10);
    if (IN(11)) REP(11) { PB
        if (F.vcu >= 128) {
            phase_gdn_pre(F, GDN_DLO, GDN_DHI, (F.vcu - 128) * NWAVES + F.wave, (F.G - 128) * NWAVES, GDN_NSPLIT, 128);
            asm volatile("s_waitcnt vmcnt(0)" ::: "memory"); __syncthreads();
            if (F.tid == 0) { __builtin_amdgcn_fence(__ATOMIC_RELEASE, "agent"); asm volatile("s_waitcnt vmcnt(0)" ::: "memory"); (void)xb_add((unsigned*)(F.ctl + CW_P10B), 1u); }
            __syncthreads(); }
        if (F.vcu >= 128) {
            pg8::Gemm gz{(const bf16*)(ws + WS_XN), (const bf16*)(ws + WS_W_CIN) + (size_t)3072 * 1024, M, 1024, DM, 0}; pg8::StaticOrder Sz; Sz.init(M, 1024, F.G - 128, F.vcu - 128, DM);
            pg8::EpiBf16<0> Ez{(bf16*)(ws + WS_Z), 1024, nullptr, 0, 0, 1.f};
            pg8::gemm_phase<pg8::EpiBf16<0>, pg8::StaticOrder, PG8_ALIGN, PG8_SP2>(F.lds + RING_OFF, gz, Sz, Ez); }
        phase_gdn_scan(F, GDN_DLO, GDN_DHI); if (GDN_DLO > 0 || GDN_DHI < 2) { __syncthreads(); phase_gdn_naive(F, GDN_DLO > 0 ? 0 : GDN_DHI, GDN_DLO > 0 ? GDN_DLO : 2); } REPBAR(11) } SEAM(11);
    if (IN(12)) REP(12) { PB phase_onorm(F); REPBAR(12) } SEAM(12);
    if (IN(13)) REP(13) { PB pg8::Gemm g{(const bf16*)(ws + WS_OG), (const bf16*)(ws + WS_W_COUT), M, DM, DM, 0}; pg8::StaticOrder S; S.init(M, DM, F.G, (int)blockIdx.x, DM);
        pg8::EpiResBf16T<false> E{nullptr, 0, (const bf16*)outp, (bf16*)outp, XRP};
        pg8::gemm_phase<pg8::EpiResBf16T<false>, pg8::StaticOrder, PG8_ALIGN, PG8_SP2>(F.lds + RING_OFF, g, S, E); REPBAR(13) } SEAM(13);
    if (IN(14)) REP(14) { PB phase_route_a(F); phase_cvt_mgu(F, args); REPBAR(14) } SEAM(14);
    if (IN(15)) REP(15) { PB phase_route_b(F); REPBAR(15) } SEAM(15);
    if (IN(16)) REP(16) { PB asm volatile(".fill 33, 4, 0xBF800000" ::: "memory"); pg8::Gemm g{(const bf16*)(ws + WS_XG), (const bf16*)(ws + WS_W_MGU), MOE_MAXROWS, 2 * DFF, DM, (size_t)7168 * 1024 * 2}; pg8::MoeOrder S; S.init((const int*)(ws + SM_META), 2 * DFF, F.G, (int)blockIdx.x, DM, false, 0);
        pg8::EpiSwiGLU E{(bf16*)(ws + WS_ACTG), DFF, nullptr, EPS};
        pg8::gemm_phase<pg8::EpiSwiGLU, pg8::MoeOrder, PG8_ALIGN, PG8_SP2>(F.lds + RING_OFF, g, S, E);
        { const int T_ = S.T, c_ = (int)blockIdx.x;
          if (T_ == 0) cvt_md_items(F, args, c_ * NWAVES + F.wave, F.G * NWAVES, 0, MD_EARLY); else if (c_ >= T_) cvt_md_items(F, args, (c_ - T_) * NWAVES + F.wave, (F.G - T_) * NWAVES, 0, MD_EARLY); }
        REPBAR(16) } SEAM(16);
    if (IN(17)) REP(17) { PB phase_cvt_md(F, args); REPBAR(17) } SEAM(17);
    if (IN(18)) REP(18) { PB pg8::Gemm g{(const bf16*)(ws + WS_ACTG), (const bf16*)(ws + WS_W_MD), MOE_MAXROWS, DM, DFF, (size_t)1024 * DFF * 2, MD_EARLY, (long long)WS_W_MD_B - (long long)WS_W_MD - (long long)MD_EARLY * 1024 * DFF * 2}; pg8::MoeOrder S; S.init((const int*)(ws + SM_META), DM, F.G, (int)blockIdx.x, DFF, true, MOE_MAXSUB);
        pg8::EpiF32 E{(bf16*)(ws + WS_Y), DM, (float*)(ws + WS_YT), S.T};
        pg8::gemm_phase<pg8::EpiF32, pg8::MoeOrder, PG8_ALIGN, PG8_SP2>(F.lds + RING_OFF, g, S, E); REPBAR(18) } SEAM(18);
    if (IN(19)) { PB phase_combine(F); }
#undef IN
#undef SEAM
}

extern "C" void kernel_launch(void* const* d_in, const int* in_sizes, int n_in, void* d_out, int out_size, void* d_ws, size_t ws_size, hipStream_t stream) {
    static int grid = 0;
    if (grid == 0) {
        if (n_in != 27 || in_sizes[0] != M * DM || out_size != M * DM || ws_size < WS_END) { fprintf(stderr, "kernel_launch: unexpected problem (n_in %d, in0 %d, out %d, ws %zu < %zu); nothing launched\n", n_in, n_in > 0 ? in_sizes[0] : -1, out_size, ws_size, (size_t)WS_END); grid = -1; return; }
        int dev = 0, cus = 0, per_cu = 0;
        if (hipGetDevice(&dev) != hipSuccess || hipDeviceGetAttribute(&cus, hipDeviceAttributeMultiprocessorCount, dev) != hipSuccess) { grid = -1; return; }
        if (hipFuncSetAttribute((const void*)mega, hipFuncAttributeMaxDynamicSharedMemorySize, LDS_BYTES) != hipSuccess) { fprintf(stderr, "kernel_launch: hipFuncSetAttribute failed\n"); grid = -1; return; }
        if (hipOccupancyMaxActiveBlocksPerMultiprocessor(&per_cu, (const void*)mega, NTHREADS, LDS_BYTES) != hipSuccess || per_cu < 1) fprintf(stderr, "kernel_launch: occupancy query says %d\n", per_cu);
        (void)hipGetLastError();
        grid = cus;
    }
    if (grid < 0) return;
    (void)hipMemsetAsync((char*)d_ws + WS_CTL, 0, CTL_ZERO_BYTES, stream);
    Args a{};
    for (int i = 0; i < 27; ++i) a.in[i] = (const float*)d_in[i];
    a.out = (float*)d_out; a.ws = (unsigned char*)d_ws; a.use_bar = 1; a.pad = 0;
    a.ph_lo = 0; a.ph_hi = 20;
    hipLaunchKernelGGL(mega, dim3(grid), dim3(NTHREADS), LDS_BYTES, stream, a);
}
```
